# Optimizing an MI355X kernel written in HIP

```python
import math
import jax, jax.numpy as jnp
from jax import lax
import numpy as np

D_MODEL = 1024
BATCH = 4
SEQ = 8192
DEPTH = 4

N_MIXERS = 2
HEAD_DIM = 64
BLOCK = 128
A_HEADS = D_MODEL // HEAD_DIM
A_KV_HEADS = A_HEADS // 8
WINDOW = 128
N_BUCKETS = 32
MAX_DISTANCE = WINDOW
B_HEADS = D_MODEL // HEAD_DIM
N_EXPERTS = 32
TOP_K = 4
D_FF = D_MODEL
SWIGLU_LIMIT = 7.0
SWIGLU_ALPHA = 1.702
MOE_ROWS = 256
DN_ALPHA = (2 * DEPTH) ** 0.25
DN_BETA = (8 * DEPTH) ** -0.25
LN_EPS = 1e-5
N_A_LAYERS = (DEPTH + 1) // 2
N_B_LAYERS = DEPTH // 2

kernel_name = 'hybrid_swa_stickbreak_moe_deepnorm'


def layer_norm(x, g, b):
    xf = x.astype(jnp.float32)
    mu = jnp.mean(xf, axis=-1, keepdims=True)
    xc = xf - mu
    var = jnp.mean(xc * xc, axis=-1, keepdims=True)
    y = xc * lax.rsqrt(var + LN_EPS) * g.astype(jnp.float32) + b.astype(jnp.float32)
    return y.astype(x.dtype)


def t5_bucket(n):
    max_exact = N_BUCKETS // 2
    nf = jnp.maximum(n, 1).astype(jnp.float32)
    large = max_exact + (jnp.log(nf / max_exact) / math.log(MAX_DISTANCE / max_exact)
                         * (N_BUCKETS - max_exact)).astype(jnp.int32)
    large = jnp.minimum(large, N_BUCKETS - 1)
    return jnp.where(n < max_exact, n, large)


def sliding_window_attention(x, w_qkv, b_qkv, sinks, w_o, b_o, rel_bias):
    bsz, s, _ = x.shape
    nb = s // BLOCK
    grp = A_HEADS // A_KV_HEADS
    qkv = x @ w_qkv + b_qkv
    q, k, v = jnp.split(qkv, [A_HEADS * HEAD_DIM, (A_HEADS + A_KV_HEADS) * HEAD_DIM], axis=-1)
    q = (q * (HEAD_DIM ** -0.5)).reshape(bsz, nb, BLOCK, A_KV_HEADS, grp, HEAD_DIM)

    def band(t):
        t = t.reshape(bsz, s, A_KV_HEADS, HEAD_DIM)
        tp = jnp.pad(t, ((0, 0), (BLOCK, 0), (0, 0), (0, 0))).reshape(bsz, nb + 1, BLOCK, A_KV_HEADS, HEAD_DIM)
        return jnp.concatenate([tp[:, :-1], tp[:, 1:]], axis=2)

    kb, vb = band(k), band(v)
    scores = jnp.einsum('bnqhgd,bnkhd->bnhgqk', q, kb).astype(jnp.float32)

    qi = jnp.arange(BLOCK)[:, None]
    ki = jnp.arange(2 * BLOCK)[None, :]
    dist = qi + BLOCK - ki
    in_win = (dist >= 0) & (dist < WINDOW)
    key_pos = jnp.arange(nb)[:, None, None] * BLOCK + ki[None] - BLOCK
    mask = in_win[None] & (key_pos >= 0)

    bias = rel_bias[t5_bucket(jnp.clip(dist, 0, None))]
    bias = bias.transpose(2, 0, 1).reshape(A_KV_HEADS, grp, BLOCK, 2 * BLOCK).astype(jnp.float32)
    scores = jnp.where(mask[None, :, None, None], scores + bias, -jnp.inf)

    sink = sinks.reshape(A_KV_HEADS, grp)[..., None, None].astype(jnp.float32)
    m = jnp.maximum(jnp.max(scores, axis=-1, keepdims=True), sink)
    p = jnp.exp(scores - m)
    p = p / (jnp.sum(p, axis=-1, keepdims=True) + jnp.exp(sink - m))
    o = jnp.einsum('bnhgqk,bnkhd->bnqhgd', p.astype(x.dtype), vb).reshape(bsz, s, A_HEADS * HEAD_DIM)
    return o @ w_o + b_o


def stick_breaking_attention(x, w_qkv, w_o):
    bsz, s, _ = x.shape
    nb = s // BLOCK
    q, k, v = jnp.split(x @ w_qkv, 3, axis=-1)
    q = (q * (HEAD_DIM ** -0.5)).reshape(bsz, nb, BLOCK, B_HEADS, HEAD_DIM).transpose(1, 0, 3, 2, 4)
    k = k.reshape(bsz, s, B_HEADS, HEAD_DIM).transpose(0, 2, 1, 3)
    v = v.reshape(bsz, s, B_HEADS, HEAD_DIM).transpose(0, 2, 1, 3)
    key_pos = jnp.arange(s)

    def one_block(args):
        i, qb = args
        z = jnp.einsum('bhqd,bhkd->bhqk', qb, k).astype(jnp.float32)
        q_pos = i * BLOCK + jnp.arange(BLOCK)
        causal = key_pos[None, :] < q_pos[:, None]
        log_1m_beta = jnp.where(causal, -jax.nn.softplus(z), 0.0)
        log_pass = lax.cumsum(log_1m_beta, axis=3, reverse=True) - log_1m_beta
        w = jnp.where(causal, jnp.exp(jax.nn.log_sigmoid(z) + log_pass), 0.0)
        return jnp.einsum('bhqk,bhkd->bhqd', w.astype(v.dtype), v)

    o = lax.map(one_block, (jnp.arange(nb), q))
    o = o.transpose(1, 0, 3, 2, 4).reshape(bsz, s, B_HEADS * HEAD_DIM)
    return o @ w_o


def moe(x, w_router, b_router, w_gate_up, b_gate_up, w_down, b_down):
    bsz, s, d = x.shape
    xt = x.reshape(-1, d)
    n_tok = xt.shape[0]
    nk = n_tok * TOP_K
    logits = (xt @ w_router + b_router).astype(jnp.float32)
    top_logits, top_idx = lax.top_k(logits, TOP_K)
    gates = jax.nn.softmax(top_logits, axis=-1)

    flat_e = top_idx.reshape(-1)
    flat_tok = jnp.arange(nk) // TOP_K
    flat_gate = gates.reshape(-1)
    order = jnp.argsort(flat_e)
    se = flat_e[order]
    counts = jnp.bincount(flat_e, length=N_EXPERTS)
    padded = (counts + MOE_ROWS - 1) // MOE_ROWS * MOE_ROWS
    pad_end = jnp.cumsum(padded)
    pad_start = pad_end - padded
    start = jnp.cumsum(counts) - counts
    dest = pad_start[se] + jnp.arange(nk) - start[se]

    n_blocks = -(-nk // MOE_ROWS) + N_EXPERTS
    n_slots = n_blocks * MOE_ROWS
    slot_tok = jnp.zeros((n_slots,), jnp.int32).at[dest].set(flat_tok[order])
    slot_gate = jnp.zeros((n_slots,), jnp.float32).at[dest].set(flat_gate[order])
    block_e = jnp.minimum(jnp.searchsorted(pad_end, jnp.arange(n_blocks) * MOE_ROWS, side='right'),
                          N_EXPERTS - 1)

    def expert_block(args):
        tok, gate, e = args
        h = xt[tok] @ w_gate_up[e] + b_gate_up[e]
        g, u = jnp.split(h, 2, axis=-1)
        g = jnp.minimum(g, SWIGLU_LIMIT)
        u = jnp.clip(u, -SWIGLU_LIMIT, SWIGLU_LIMIT)
        act = (u + 1.0) * (g * jax.nn.sigmoid(SWIGLU_ALPHA * g))
        y = act @ w_down[e] + b_down[e]
        return y * gate[:, None].astype(y.dtype)

    ys = lax.map(expert_block, (slot_tok.reshape(n_blocks, MOE_ROWS),
                                slot_gate.reshape(n_blocks, MOE_ROWS), block_e))
    out = jnp.zeros_like(xt).at[slot_tok].add(ys.reshape(n_slots, d))
    return out.reshape(bsz, s, d)


def setup_inputs(seed: int = 0) -> dict:
    key = jax.random.key(seed)
    ks = jax.random.split(key, 24)
    f32 = jnp.float32
    qkv_a = (A_HEADS + 2 * A_KV_HEADS) * HEAD_DIM
    qkv_b = 3 * B_HEADS * HEAD_DIM
    a_col_scale = jnp.concatenate([jnp.ones(((A_HEADS + A_KV_HEADS) * HEAD_DIM,), f32),
                                   jnp.full((A_KV_HEADS * HEAD_DIM,), DN_BETA, f32)])
    b_col_scale = jnp.concatenate([jnp.ones((2 * B_HEADS * HEAD_DIM,), f32),
                                   jnp.full((B_HEADS * HEAD_DIM,), DN_BETA, f32)])
    nrm = lambda k, shape: jax.random.normal(k, shape, f32)
    return {
        'x': nrm(ks[0], (BATCH, SEQ, D_MODEL)),
        'rel_bias': 0.2 * nrm(ks[1], (N_BUCKETS, A_HEADS)),
        'a_w_qkv': nrm(ks[2], (N_A_LAYERS, D_MODEL, qkv_a)) * D_MODEL ** -0.5 * a_col_scale,
        'a_b_qkv': 0.02 * nrm(ks[3], (N_A_LAYERS, qkv_a)),
        'a_sinks': nrm(ks[4], (N_A_LAYERS, A_HEADS)),
        'a_w_o': nrm(ks[5], (N_A_LAYERS, A_HEADS * HEAD_DIM, D_MODEL)) * (A_HEADS * HEAD_DIM) ** -0.5 * DN_BETA,
        'a_b_o': 0.02 * nrm(ks[6], (N_A_LAYERS, D_MODEL)),
        'b_w_qkv': nrm(ks[7], (N_B_LAYERS, D_MODEL, qkv_b)) * D_MODEL ** -0.5 * b_col_scale,
        'b_w_o': nrm(ks[8], (N_B_LAYERS, B_HEADS * HEAD_DIM, D_MODEL)) * (B_HEADS * HEAD_DIM) ** -0.5 * DN_BETA,
        'ln1_g': 1.0 + 0.02 * nrm(ks[9], (DEPTH, D_MODEL)),
        'ln1_b': 0.02 * nrm(ks[10], (DEPTH, D_MODEL)),
        'ln2_g': 1.0 + 0.02 * nrm(ks[11], (DEPTH, D_MODEL)),
        'ln2_b': 0.02 * nrm(ks[12], (DEPTH, D_MODEL)),
        'moe_w_router': nrm(ks[13], (DEPTH, D_MODEL, N_EXPERTS)) * D_MODEL ** -0.5,
        'moe_b_router': 0.01 * nrm(ks[14], (DEPTH, N_EXPERTS)),
        'moe_w_gate_up': nrm(ks[15], (DEPTH, N_EXPERTS, D_MODEL, 2 * D_FF)) * D_MODEL ** -0.5,
        'moe_b_gate_up': 0.02 * nrm(ks[16], (DEPTH, N_EXPERTS, 2 * D_FF)),
        'moe_w_down': nrm(ks[17], (DEPTH, N_EXPERTS, D_FF, D_MODEL)) * D_FF ** -0.5 * DN_BETA,
        'moe_b_down': 0.02 * nrm(ks[18], (DEPTH, N_EXPERTS, D_MODEL)),
    }


def reference(x, rel_bias, a_w_qkv, a_b_qkv, a_sinks, a_w_o, a_b_o, b_w_qkv, b_w_o,
              ln1_g, ln1_b, ln2_g, ln2_b, moe_w_router, moe_b_router,
              moe_w_gate_up, moe_b_gate_up, moe_w_down, moe_b_down):
    for i in range(DEPTH):
        j = i // N_MIXERS
        if i % N_MIXERS == 0:
            y = sliding_window_attention(x, a_w_qkv[j], a_b_qkv[j], a_sinks[j], a_w_o[j], a_b_o[j], rel_bias)
        else:
            y = stick_breaking_attention(x, b_w_qkv[j], b_w_o[j])
        x = layer_norm(DN_ALPHA * x + y, ln1_g[i], ln1_b[i])
        y = moe(x, moe_w_router[i], moe_b_router[i], moe_w_gate_up[i], moe_b_gate_up[i],
                moe_w_down[i], moe_b_down[i])
        x = layer_norm(DN_ALPHA * x + y, ln2_g[i], ln2_b[i])
    return x
```

```cpp
#include <hip/hip_runtime.h>
#include <cstdio>
#include <cstdint>
#ifndef FP8_EMU
#define FP8_EMU 0
#endif
#ifndef RES16_EMU
#define RES16_EMU 0
#endif
#ifndef PROBE_REPEAT
#define PROBE_REPEAT 0
#endif

#define GAS __attribute__((address_space(1)))
#define LAS __attribute__((address_space(3)))
typedef unsigned short bf16;
typedef unsigned v4u __attribute__((ext_vector_type(4)));
typedef unsigned v2u __attribute__((ext_vector_type(2)));
typedef float f32x4 __attribute__((ext_vector_type(4)));
typedef float f32x16 __attribute__((ext_vector_type(16)));
typedef short bf16x8 __attribute__((ext_vector_type(8)));

constexpr int BATCH = 4, SEQ = 8192, T = BATCH * SEQ, D = 1024, DEPTH = 4, NEXP = 32, TOPK = 4, HD = 64, NH = 16;
constexpr int QKVA = 1280, QKVB = 3072, DFF = 1024;
constexpr int NSLOT = (T * TOPK / 256 + NEXP) * 256;
constexpr int MAXMT = NSLOT / 256;
constexpr float LN_EPS = 1e-5f;
constexpr float DN_ALPHA = 1.681792830507429f;
constexpr float LOG2E = 1.4426950408889634f;
constexpr float QSCALE = 0.125f * LOG2E;
constexpr float SB_EXIT = -48.0f;

constexpr size_t MiB = 1u << 20;
constexpr size_t WS_CTL = 0, CTL_ZERO_BYTES = 1 * MiB;
constexpr size_t WS_BT = 1 * MiB;
constexpr size_t WS_WRT = 1 * MiB + 65536;
constexpr size_t WS_WQKVA = 2 * MiB, WS_WOA = 8 * MiB, WS_WQKVB = 12 * MiB, WS_WOB = 24 * MiB;
constexpr size_t WS_WGU = 32 * MiB, WS_WD = 544 * MiB;
constexpr size_t WS_XF = 800 * MiB, WS_XB = 928 * MiB, WS_QKV = 992 * MiB, WS_O = 1184 * MiB, WS_Z = 1248 * MiB;
constexpr size_t WS_X1F = 1376 * MiB, WS_X1B = 1504 * MiB, WS_X18 = 1568 * MiB, WS_ACT = 1840 * MiB, WS_Y = 2112 * MiB;
constexpr size_t WS_TOPE = 2384 * MiB, WS_TOPG = WS_TOPE + 512 * 1024, WS_POS = WS_TOPG + 512 * 1024;
constexpr size_t WS_LIST = 2386 * MiB, WS_LGATE = 2390 * MiB;
constexpr size_t WS_LISTK = 2394 * MiB;
constexpr size_t WS_END = 2398 * MiB;
constexpr int CW_CNT = 32768, CNT_STRIDE = 64, CNT_LAYER = NEXP * CNT_STRIDE;
constexpr int CW_NMT = 512;
constexpr int CW_TILEE = 1024;
constexpr int CW_PADS = 8192;
constexpr int CW_BAR = 16384;

constexpr int NWAVES = 8, NTHREADS = 512;
#ifndef CONV_INFLIGHT
#define CONV_INFLIGHT 1
#endif
#ifndef CONV_GU
#define CONV_GU 32
#endif
#ifndef CONV_CUS_A
#define CONV_CUS_A 108
#endif
#ifndef CONV_CUS
#define CONV_CUS 98
#endif
constexpr int LDS_BYTES = 147456;
constexpr int LDSCTL_OFF = 133120;
constexpr int LT_E = LDSCTL_OFF + 256, LT_TE = LT_E + 4 * MAXMT, LT_PSTART = LT_TE + 4 * MAXMT, LT_CNT = LT_PSTART + 128, LT_NMT = LT_CNT + 128;
constexpr int LT_SB = LT_NMT + 16;
static_assert(LT_SB % 16 == 0 && LT_SB + 2 * 3072 + 1024 <= LDS_BYTES && 8 * 64 * 65 * 4 <= LDSCTL_OFF, "LDS control area");

struct Args { const float* in[19]; float* out; unsigned char* ws; int ph_lo, ph_hi; };

struct Frame {
    LAS unsigned char* lds;
    int tid, lane, wave, gw, NGW;
};

__device__ __forceinline__ unsigned f2bf(float f) { unsigned u = __builtin_bit_cast(unsigned, f); return (u + 0x7fffu + ((u >> 16) & 1u)) >> 16; }
__device__ __forceinline__ unsigned pk2(float lo, float hi) { return f2bf(lo) | (f2bf(hi) << 16); }
typedef float f32x2_t __attribute__((ext_vector_type(2))); typedef __bf16 bf16x2_t __attribute__((ext_vector_type(2)));
__device__ __forceinline__ unsigned cvtpk(float lo, float hi) { const f32x2_t v = {lo, hi}; const bf16x2_t b = __builtin_convertvector(v, bf16x2_t); return __builtin_bit_cast(unsigned, b); }
__device__ __forceinline__ void unpack8(const v4u w, float (&f)[8]) {
    f[0] = __builtin_bit_cast(float, w.x << 16); f[1] = __builtin_bit_cast(float, w.x & 0xffff0000u); f[2] = __builtin_bit_cast(float, w.y << 16); f[3] = __builtin_bit_cast(float, w.y & 0xffff0000u);
    f[4] = __builtin_bit_cast(float, w.z << 16); f[5] = __builtin_bit_cast(float, w.z & 0xffff0000u); f[6] = __builtin_bit_cast(float, w.w << 16); f[7] = __builtin_bit_cast(float, w.w & 0xffff0000u);
}
__device__ __forceinline__ v4u pack8(const float (&f)[8]) { v4u w; w.x = cvtpk(f[0], f[1]); w.y = cvtpk(f[2], f[3]); w.z = cvtpk(f[4], f[5]); w.w = cvtpk(f[6], f[7]); return w; }
__device__ __forceinline__ float bf16r(float x) { return RES16_EMU ? __builtin_bit_cast(float, f2bf(x) << 16) : x; }
__device__ __forceinline__ f32x4 bf16r4(f32x4 v) { f32x4 r; r.x = bf16r(v.x); r.y = bf16r(v.y); r.z = bf16r(v.z); r.w = bf16r(v.w); return r; }
__device__ __forceinline__ unsigned pk4_fp8(float a, float b, float c, float d) {
    int r = __builtin_amdgcn_cvt_pk_fp8_f32(a, b, 0, false); r = __builtin_amdgcn_cvt_pk_fp8_f32(c, d, r, true); return (unsigned)r;
}
constexpr float Y_SCALE = 16.0f;
constexpr float WD_SCALE = 64.0f, ACT_SCALE = 4.0f;
constexpr float WGU_SCALE = 32.0f;
__device__ __forceinline__ float e4m3r(float x) {
    const float ax = fabsf(x);
    if (ax < 0.015625f) return copysignf(rintf(ax * 512.0f) * (1.0f / 512.0f), x);
    unsigned u = __builtin_bit_cast(unsigned, x); u += 0x7FFFFu + ((u >> 20) & 1u); u &= 0xFFF00000u;
    const float r = __builtin_bit_cast(float, u); return fminf(fmaxf(r, -448.0f), 448.0f);
}
__device__ __forceinline__ float bf2f(unsigned short b) { return __builtin_bit_cast(float, (unsigned)b << 16); }
__device__ __forceinline__ float shfl_f(float v, int src) { return __builtin_bit_cast(float, __builtin_amdgcn_ds_bpermute(src << 2, __builtin_bit_cast(int, v))); }
__device__ __forceinline__ int shfl_i(int v, int src) { return __builtin_amdgcn_ds_bpermute(src << 2, v); }
__device__ __forceinline__ float wave_sum(float v, int lane) {
#pragma unroll
    for (int o = 1; o < 64; o <<= 1) v += shfl_f(v, lane ^ o);
    return v;
}
__device__ __forceinline__ float wave_max(float v, int lane) {
#pragma unroll
    for (int o = 1; o < 64; o <<= 1) v = fmaxf(v, shfl_f(v, lane ^ o));
    return v;
}
__device__ __forceinline__ int crow(int r, int hi) { return (r & 3) + 8 * (r >> 2) + 4 * hi; }

typedef GAS unsigned gu32;
#define RLX_AGENT __ATOMIC_RELAXED, __HIP_MEMORY_SCOPE_AGENT
#define XB_TMO      128
#define XB_XCNT(j)  (256  + 64 * (j))
#define XB_XSUB(j)  (1280 + 64 * (j))
#define XB_XGEN(j)  (2304 + 64 * (j))
#define XB_TOP      3328
#define XB_TOPGEN   3392
#define XCD_BAR_WORDS 3456
#define XB_SPIN_CAP (1u << 18)

__device__ __forceinline__ unsigned xb_ld(unsigned* p)              { return __hip_atomic_load(p, __ATOMIC_RELAXED, __HIP_MEMORY_SCOPE_AGENT); }
__device__ __forceinline__ unsigned xb_add(unsigned* p, unsigned v) { return __hip_atomic_fetch_add(p, v, __ATOMIC_RELAXED, __HIP_MEMORY_SCOPE_AGENT); }
__device__ __forceinline__ unsigned xb_xcc_id() { return (unsigned)__builtin_amdgcn_s_getreg((3 << 11) | 20) & 0xFu; }
#define XB_SPIN(cond, bar) do { unsigned _sp = 0; while (cond) { __builtin_amdgcn_s_sleep(1); \
    if ((++_sp & 255u) == 0u) { if (xb_ld(&(bar)[XB_TMO])) break; if (_sp > XB_SPIN_CAP) { atomicAdd(&(bar)[XB_TMO], 1u); break; } } } } while (0)

struct XcdBarrier {
    unsigned* bar; unsigned x;
    volatile LAS unsigned* st;
};

__device__ __forceinline__ XcdBarrier xcd_barrier_post(unsigned* bar, volatile LAS unsigned* st) {
    XcdBarrier b; b.bar = bar; b.x = xb_xcc_id(); b.st = st;
    if (threadIdx.x == 0) (void)xb_add(&bar[XB_XCNT(b.x)], 1u);
    return b;
}
__device__ __forceinline__ void xcd_barrier_complete(unsigned* bar, unsigned x, unsigned& nloc, unsigned& nx) {
    const unsigned G = gridDim.x * gridDim.y * gridDim.z;
    unsigned sum, cnt, mine, sp = 0u;
    for (;;) {
        sum = 0u; cnt = 0u; mine = 0u;
#pragma unroll
        for (unsigned j = 0; j < 16; ++j) { const unsigned c = xb_ld(&bar[XB_XCNT(j)]); sum += c; cnt += (c > 0u) ? 1u : 0u; mine = (j == x) ? c : mine; }
        if (sum == G) break;
        __builtin_amdgcn_s_sleep(1);
        if ((++sp & 255u) == 0u) { if (xb_ld(&bar[XB_TMO])) break; if (sp > XB_SPIN_CAP) { atomicAdd(&bar[XB_TMO], 1u); break; } }
    }
    nloc = mine > 0u ? mine : 1u; nx = cnt > 0u ? cnt : 1u;
}

__device__ __forceinline__ void xcd_barrier(const XcdBarrier& b) {
    asm volatile("s_waitcnt vmcnt(0)" ::: "memory");
    __syncthreads();
    if (threadIdx.x == 0) {
        unsigned* bar = b.bar;
        __builtin_amdgcn_s_waitcnt(0);
        unsigned nloc = b.st[0], nx = b.st[1];
        if (nloc == 0u) { xcd_barrier_complete(bar, b.x, nloc, nx); b.st[0] = nloc; b.st[1] = nx; }
        const unsigned old = xb_add(&bar[XB_XSUB(b.x)], 1u);
        const unsigned gen = old / nloc;
        if (old + 1u == (gen + 1u) * nloc) {
            __builtin_amdgcn_fence(__ATOMIC_RELEASE, "agent");
            asm volatile("s_waitcnt vmcnt(0)" ::: "memory");
            const unsigned og = xb_add(&bar[XB_TOP], 1u);
            const unsigned tg = og / nx;
            if (og + 1u == (tg + 1u) * nx) xb_add(&bar[XB_TOPGEN], 1u);
            else XB_SPIN(xb_ld(&bar[XB_TOPGEN]) == tg, bar);
            __builtin_amdgcn_fence(__ATOMIC_ACQUIRE, "agent");
            xb_add(&bar[XB_XGEN(b.x)], 1u);
            asm volatile("s_waitcnt vmcnt(0)" ::: "memory");
        } else {
            XB_SPIN(xb_ld(&bar[XB_XGEN(b.x)]) == gen, bar);
            __builtin_amdgcn_fence(__ATOMIC_ACQUIRE, "agent");
            asm volatile("s_waitcnt vmcnt(0)" ::: "memory");
        }
    }
    __syncthreads();
}

template <int EMU> __device__ __forceinline__ void transpose_item(const float* W, int K, int N, bf16* WT, int k0, int n0, int dst_row0, LAS float* scr, int lane) {
    float wv[32];
#pragma unroll
    for (int i = 0; i < 32; ++i) wv[i] = __builtin_nontemporal_load(W + (size_t)(k0 + 2 * i + (lane >> 5)) * N + n0 + (lane & 31));
#pragma unroll
    for (int i = 0; i < 32; ++i) { float w_ = wv[i]; if (EMU == 1) w_ = e4m3r(w_ * 32.0f) * (1.0f / 32.0f); if (EMU == 2) w_ = e4m3r(w_ * 64.0f) * (1.0f / 64.0f); scr[(2 * i + (lane >> 5)) * 33 + (lane & 31)] = w_; }
    asm volatile("s_waitcnt lgkmcnt(0)" ::: "memory");
    const int c = lane & 7;
#pragma unroll
    for (int j = 0; j < 4; ++j) { const int n = (lane >> 3) + 8 * j; const LAS float* s = scr + (8 * c) * 33 + n;
        v4u o; o.x = pk2(s[0 * 33], s[1 * 33]); o.y = pk2(s[2 * 33], s[3 * 33]); o.z = pk2(s[4 * 33], s[5 * 33]); o.w = pk2(s[6 * 33], s[7 * 33]);
        *(v4u*)(WT + (size_t)(dst_row0 + n) * K + k0 + 8 * c) = o; }
    asm volatile("s_waitcnt lgkmcnt(0)" ::: "memory");
}
__device__ __forceinline__ void transpose_item8(const float* W, int K, int N, unsigned char* WT, int k0, int n0, int dst_row0, LAS float* scr, int lane) {
    float wv[32];
#pragma unroll
    for (int i = 0; i < 32; ++i) wv[i] = __builtin_nontemporal_load(W + (size_t)(k0 + 2 * i + (lane >> 5)) * N + n0 + (lane & 31));
#pragma unroll
    for (int i = 0; i < 32; ++i) scr[(2 * i + (lane >> 5)) * 33 + (lane & 31)] = wv[i] * WGU_SCALE;
    asm volatile("s_waitcnt lgkmcnt(0)" ::: "memory");
    const int c = lane & 7;
#pragma unroll
    for (int j = 0; j < 4; ++j) { const int n = (lane >> 3) + 8 * j; const LAS float* sp = scr + (8 * c) * 33 + n;
        v2u o; o.x = pk4_fp8(sp[0 * 33], sp[1 * 33], sp[2 * 33], sp[3 * 33]); o.y = pk4_fp8(sp[4 * 33], sp[5 * 33], sp[6 * 33], sp[7 * 33]);
        *(v2u*)(WT + (size_t)(dst_row0 + n) * K + k0 + 8 * c) = o; }
    asm volatile("s_waitcnt lgkmcnt(0)" ::: "memory");
}
constexpr int CONV_SLOT = 64 * 65 * 4;
template <int OUT8>
__device__ __forceinline__ void transpose_item64(const float* W, int K, int N, void* WTv, int k0, int n0, int dst_row0, LAS float* scr, int lane) {
    f32x4 wv[16];
    const float* src = W + (size_t)(k0 + (lane >> 4)) * N + n0 + 4 * (lane & 15);
#pragma unroll
    for (int i = 0; i < 16; ++i) wv[i] = __builtin_nontemporal_load((const f32x4*)(src + (size_t)(4 * i) * N));
    LAS float* dstp = scr + (lane >> 4) * 65 + 4 * (lane & 15);
#pragma unroll
    for (int i = 0; i < 16; ++i) { const float sc_ = OUT8 == 1 ? WGU_SCALE : (OUT8 == 2 ? WD_SCALE : 1.0f); dstp[(4 * i) * 65 + 0] = wv[i].x * sc_; dstp[(4 * i) * 65 + 1] = wv[i].y * sc_; dstp[(4 * i) * 65 + 2] = wv[i].z * sc_; dstp[(4 * i) * 65 + 3] = wv[i].w * sc_; }
    asm volatile("s_waitcnt lgkmcnt(0)" ::: "memory");
    const int c = lane & 7;
#pragma unroll
    for (int j = 0; j < 8; ++j) { const int n = (lane >> 3) + 8 * j; const LAS float* sp = scr + (8 * c) * 65 + n;
        if constexpr (OUT8 != 0) { v2u o; o.x = pk4_fp8(sp[0 * 65], sp[1 * 65], sp[2 * 65], sp[3 * 65]); o.y = pk4_fp8(sp[4 * 65], sp[5 * 65], sp[6 * 65], sp[7 * 65]);
            *(v2u*)((unsigned char*)WTv + (size_t)(dst_row0 + n) * K + k0 + 8 * c) = o; }
        else { v4u o; o.x = pk2(sp[0 * 65], sp[1 * 65]); o.y = pk2(sp[2 * 65], sp[3 * 65]); o.z = pk2(sp[4 * 65], sp[5 * 65]); o.w = pk2(sp[6 * 65], sp[7 * 65]);
            *(v4u*)((bf16*)WTv + (size_t)(dst_row0 + n) * K + k0 + 8 * c) = o; } }
    asm volatile("s_waitcnt lgkmcnt(0)" ::: "memory");
}
template <int OUT8, bool GU>
__device__ __forceinline__ void convert_weights64(Frame& F, const float* W, void* WT, int nmat, int K, int N, LAS float* scr) {
    const int nblk = N / 64, kblk = K / 64, per = nblk * kblk, total = nmat * per; const size_t esz = OUT8 ? 1 : 2;
    for (int it = F.gw; it < total; it += F.NGW) {
        const int mat = it / per, r = it % per, kb = r % kblk, nb = r / kblk, n0 = nb * 64;
        int dr = n0;
        if (GU) { const int half = n0 / DFF, j0 = n0 % DFF; dr = 256 * (j0 / 128) + 128 * half + (j0 % 128); }
        transpose_item64<OUT8>(W + (size_t)mat * K * N, K, N, (unsigned char*)WT + (size_t)mat * K * N * esz, kb * 64, n0, dr, scr, F.lane);
    }
}
template <int OUT8, bool GU>
__device__ __forceinline__ void convert_stream(int gw, int ngw, int lane, const float* W, unsigned char* WT, int nmat, int K, int N, LAS float* scr) {
    const int nblk = N / 64, kblk = K / 64, per = nblk * kblk, total = nmat * per;
    const float sc_ = OUT8 == 1 ? WGU_SCALE : WD_SCALE;
    auto request = [&](f32x4 (&wv)[16], int it) {
        const int mat = it / per, r = it % per, kb = r % kblk, nb = r / kblk; const float* src = W + (size_t)mat * K * N + (size_t)(kb * 64 + (lane >> 4)) * N + nb * 64 + 4 * (lane & 15);
#pragma unroll
        for (int i = 0; i < 16; ++i) wv[i] = __builtin_nontemporal_load((const f32x4*)(src + (size_t)(4 * i) * N)); };
    auto stage = [&](const f32x4 (&wv)[16]) {
        LAS float* dstp = scr + (lane >> 4) * 65 + 4 * (lane & 15);
#pragma unroll
        for (int i = 0; i < 16; ++i) { dstp[(4 * i) * 65 + 0] = wv[i].x * sc_; dstp[(4 * i) * 65 + 1] = wv[i].y * sc_; dstp[(4 * i) * 65 + 2] = wv[i].z * sc_; dstp[(4 * i) * 65 + 3] = wv[i].w * sc_; } };
    auto finish = [&](int it) {
        const int mat = it / per, r = it % per, kb = r % kblk, nb = r / kblk, n0 = nb * 64;
        int dr = n0;
        if (GU) { const int half = n0 / DFF, j0 = n0 % DFF; dr = 256 * (j0 / 128) + 128 * half + (j0 % 128); }
        asm volatile("s_waitcnt lgkmcnt(0)" ::: "memory");
        const int c = lane & 7; unsigned char* wt = WT + (size_t)mat * K * N + kb * 64 + 8 * c;
#pragma unroll
        for (int j = 0; j < 8; ++j) { const int n = (lane >> 3) + 8 * j; const LAS float* sp = scr + (8 * c) * 65 + n;
            v2u o; o.x = pk4_fp8(sp[0 * 65], sp[1 * 65], sp[2 * 65], sp[3 * 65]); o.y = pk4_fp8(sp[4 * 65], sp[5 * 65], sp[6 * 65], sp[7 * 65]);
            *(v2u*)(wt + (size_t)(dr + n) * K) = o; }
        asm volatile("s_waitcnt lgkmcnt(0)" ::: "memory"); };
    if (CONV_INFLIGHT == 1) {
        int it = gw; f32x4 wa[16];
        if (it < total) request(wa, it);
        while (it < total) { stage(wa); const int nx = it + ngw; if (nx < total) request(wa, nx); finish(it); it = nx; }
        return;
    }
    int itA = gw, itB = gw + ngw;
    f32x4 wa[16], wb[16];
    if (itA < total) request(wa, itA);
    if (itB < total) request(wb, itB);
    while (itA < total) {
        stage(wa); { const int nx = itA + 2 * ngw; if (nx < total) request(wa, nx); finish(itA); itA = nx; }
        if (itB < total) { stage(wb); const int nx = itB + 2 * ngw; if (nx < total) request(wb, nx); finish(itB); itB = nx; }
    }
}
template <bool GU>
__device__ __forceinline__ void convert_weights8(Frame& F, const float* W, unsigned char* WT, int nmat, int K, int N, LAS float* scr) {
    const int nblk = N / 32, kblk = K / 64, per = nblk * kblk, total = nmat * per;
    for (int it = F.gw; it < total; it += F.NGW) {
        const int mat = it / per, r = it % per, kb = r / nblk, nb = r % nblk, n0 = nb * 32;
        int dr = n0;
        if (GU) { const int half = n0 / DFF, j0 = n0 % DFF; dr = 256 * (j0 / 128) + 128 * half + (j0 % 128); }
        transpose_item8(W + (size_t)mat * K * N, K, N, WT + (size_t)mat * K * N, kb * 64, n0, dr, scr, F.lane);
    }
}
template <bool GU, int EMU = 0>
__device__ __forceinline__ void convert_weights(Frame& F, const float* W, bf16* WT, int nmat, int K, int N, LAS float* scr) {
    const int nblk = N / 32, kblk = K / 64, per = nblk * kblk, total = nmat * per;
    for (int it = F.gw; it < total; it += F.NGW) {
        const int mat = it / per, r = it % per, kb = r / nblk, nb = r % nblk, n0 = nb * 32;
        int dr = n0;
        if (GU) { const int half = n0 / DFF, j0 = n0 % DFF; dr = 256 * (j0 / 128) + 128 * half + (j0 % 128); }
        transpose_item<EMU>(W + (size_t)mat * K * N, K, N, WT + (size_t)mat * K * N, kb * 64, n0, dr, scr, F.lane);
    }
}
__device__ __forceinline__ int t5_bucket(int n) {
    if (n < 16) return n;
    int l = 16 + (int)(logf((float)n / 16.0f) / logf(8.0f) * 16.0f);
    return l < 31 ? l : 31;
}
__device__ __forceinline__ void prologue_phase(Frame& F, const Args& a) {
    unsigned char* ws = a.ws;
    LAS float* scr = (LAS float*)(F.lds + F.wave * CONV_SLOT);
    const bool cvcu = CONV_CUS > 0 && (int)gridDim.x >= CONV_CUS + 64;
    if (!cvcu) convert_weights64<1, true >(F, a.in[15], ws + WS_WGU, DEPTH * NEXP, D, 2 * DFF, scr);
    else for (int l = 0; l < DEPTH; ++l) convert_weights64<1, true >(F, a.in[15] + (size_t)(l * NEXP + CONV_GU) * D * 2 * DFF, ws + WS_WGU + (size_t)(l * NEXP + CONV_GU) * D * 2 * DFF, NEXP - CONV_GU, D, 2 * DFF, scr);
    if (!cvcu) convert_weights64<2, false>(F, a.in[17], ws + WS_WD, DEPTH * NEXP, DFF, D, scr);
    convert_weights64<1, false>(F, a.in[2], ws + WS_WQKVA, 2, D, QKVA, scr);
    convert_weights64<1, false>(F, a.in[5], ws + WS_WOA, 2, D, D, scr);
    convert_weights64<1, false>(F, a.in[7], ws + WS_WQKVB, 2, D, QKVB, scr);
    convert_weights64<1, false>(F, a.in[8], ws + WS_WOB, 2, D, D, scr);
    const float* x = a.in[0]; unsigned char* xb = ws + WS_XB;
    for (int m = F.gw; m < T; m += F.NGW) {
        const f32x4* xr = (const f32x4*)(x + (size_t)m * D) + F.lane; unsigned* o = (unsigned*)(xb + (size_t)m * D) + F.lane;
#pragma unroll
        for (int j = 0; j < 4; ++j) { const f32x4 v = xr[64 * j]; o[64 * j] = pk4_fp8(v.x, v.y, v.z, v.w);
            v2u w; w.x = cvtpk(v.x, v.y); w.y = cvtpk(v.z, v.w); ((v2u*)((bf16*)(ws + WS_XF) + (size_t)m * D))[F.lane + 64 * j] = w; }
    }
    { const float* wr = a.in[13]; bf16* wt = (bf16*)(ws + WS_WRT);
      for (int idx = blockIdx.x * NTHREADS + F.tid; idx < DEPTH * NEXP * D; idx += gridDim.x * NTHREADS) {
          const int l = idx / (NEXP * D), e = (idx / D) % NEXP, k = idx % D; const float w = wr[((size_t)l * D + k) * NEXP + e];
          const unsigned h = f2bf(w); const float wl = w - __builtin_bit_cast(float, h << 16);
          wt[((size_t)(l * 2 + 0) * NEXP + e) * D + k] = (bf16)h; wt[((size_t)(l * 2 + 1) * NEXP + e) * D + k] = (bf16)f2bf(wl); } }
    if (blockIdx.x == 0) { float* bt = (float*)(ws + WS_BT); const float* rb = a.in[1];
        for (int i = F.tid; i < NH * 128; i += NTHREADS) { const int h = i >> 7, dist = i & 127; bt[i] = rb[t5_bucket(dist) * NH + h] * LOG2E; } }
}

__device__ __forceinline__ void wave_gemm2(const bf16* Arow, const bf16* B0row, const bf16* B1row, int K, f32x16& acc0, f32x16& acc1) {
    for (int k0 = 0; k0 < K; k0 += 16) {
        const bf16x8 av = *(const bf16x8*)(Arow + k0), b0 = *(const bf16x8*)(B0row + k0), b1 = *(const bf16x8*)(B1row + k0);
        acc0 = __builtin_amdgcn_mfma_f32_32x32x16_bf16(av, b0, acc0, 0, 0, 0);
        acc1 = __builtin_amdgcn_mfma_f32_32x32x16_bf16(av, b1, acc1, 0, 0, 0);
    }
}
template <class E>
__device__ __forceinline__ void gemm_dense_simple(Frame& F, const bf16* A, const bf16* Bt, int M, int N, int K, const E& epi) {
    const int ntn = N / 64, total = (M / 32) * ntn, j = F.lane & 31, h = F.lane >> 5;
    for (int it = F.gw; it < total; it += F.NGW) {
        const int tm = it / ntn, tn = it % ntn, row0 = tm * 32, col0 = tn * 64;
        f32x16 acc0 = {}, acc1 = {};
        wave_gemm2(A + (size_t)(row0 + j) * K + 8 * h, Bt + (size_t)(col0 + j) * K + 8 * h, Bt + (size_t)(col0 + 32 + j) * K + 8 * h, K, acc0, acc1);
#pragma unroll
        for (int r = 0; r < 16; ++r) { epi(row0 + crow(r, h), col0 + j, acc0[r]); epi(row0 + crow(r, h), col0 + 32 + j, acc1[r]); }
    }
}

namespace pg8 {
#define PG8_LAS __attribute__((address_space(3)))
typedef unsigned short bf16_t;
typedef short bf16x8 __attribute__((ext_vector_type(8)));
typedef float f32x4 __attribute__((ext_vector_type(4)));
typedef unsigned u32x4 __attribute__((ext_vector_type(4)));
typedef int v4i_t __attribute__((ext_vector_type(4)));
constexpr int LIST_STRIDE = 32768;
constexpr int BM = 256, BK = 64, HALF = 128, HTB = HALF * BK * 2  , STAGE_BYTES = 8 * HTB, NXCD = 8, WGM = 4;

__host__ __device__ __forceinline__ int lds_byte(int r, int c) { const int st = (r >> 4) * 2 + (c >> 5), rr = r & 15, cc = c & 31, ob = rr * 64 + cc * 2; return st * 1024 + (ob ^ (((ob >> 9) & 1) << 5)); }
__host__ __device__ __forceinline__ void stage_rc(int b, int& R, int& C) { const int st = b / 1024, sb = b % 1024, swz = sb ^ (((sb >> 9) & 1) << 5); R = (st >> 1) * 16 + swz / 64; C = (st & 1) * 32 + (swz % 64) / 2; }
__host__ __device__ __forceinline__ int perm32(int rho) { const int n = rho >> 4, i = rho & 15; return 8 * (i >> 2) + 4 * n + (i & 3); }

struct Unit { int pm, pn, e, te, cnt; };
struct Gemm { const bf16_t* A; const bf16_t* Bt; int M, N, K; size_t bstride; const int* list; int sb_off; };

struct StaticOrder {
    int nM, nN, nwg, G, c;
    __host__ __device__ void init(int M, int N, int G_, int c_) { nM = M / BM; nN = N / BM; nwg = nM * nN; G = G_; c = c_; }
    __host__ __device__ bool next(int i, Unit& u) const {
        const long L = (long)i * G + c; if (L >= nwg) return false;
        int wgid = (int)L; { const int q = nwg / NXCD, r = nwg % NXCD, xcd = wgid % NXCD, off = wgid / NXCD; wgid = (xcd < r ? xcd * (q + 1) : r * (q + 1) + (xcd - r) * q) + off; }
        const int nig = WGM * nN, gid = wgid / nig, fm = gid * WGM, gsz = (nM - fm) < WGM ? (nM - fm) : WGM;
        u.pm = fm + ((wgid % nig) % gsz); u.pn = (wgid % nig) / gsz; u.e = 0; u.te = 0; u.cnt = 0; return true;
    }
    __host__ __device__ bool next_lane(int i, Unit& u) const { return next(i, u); }
    __device__ __forceinline__ void a_ready(const Unit&) const {}
    __device__ __forceinline__ void done(const Unit&) const {}
};

__device__ __forceinline__ unsigned cvt_pk_bf16(float lo, float hi) { unsigned r; asm volatile("v_cvt_pk_bf16_f32 %0, %1, %2" : "=v"(r) : "v"(lo), "v"(hi)); return r; }
typedef float f32x2 __attribute__((ext_vector_type(2)));
__device__ __forceinline__ f32x2 gelu_pk(f32x2 v) {
    const f32x2 av = __builtin_elementwise_abs(v), d = av * 0.2316418882f + 1.0f;
    f32x2 t; t.x = __builtin_amdgcn_rcpf(d.x); t.y = __builtin_amdgcn_rcpf(d.y);
    f32x2 q = t * 0.5307027145f + (-0.7265760135f); q = q * t + 0.7107068705f; q = q * t + (-0.142248368f); q = q * t + 0.127414796f; q = q * t;
    const f32x2 s = (v * v) * (-0.72134752044f);
    f32x2 e; e.x = __builtin_amdgcn_exp2f(s.x); e.y = __builtin_amdgcn_exp2f(s.y);
    const f32x2 m = v * (q * e), r = v - m;
    f32x2 o; o.x = v.x < 0.f ? m.x : r.x; o.y = v.y < 0.f ? m.y : r.y; return o;
}

template <int ACT  > struct EpiBf16 {
    static constexpr bool PERM = true, AFTER_DRAIN = false; static constexpr int NSB = 1; static_assert(ACT == 0 || ACT == 1, "EpiBf16: ACT is 0 (none) or 1 (gelu_pk)");
    __device__ __forceinline__ const void* sb_src(const Unit& u, int, int lane) const { return bias ? (const void*)(bias + u.pn * BM + lane * 4) : nullptr; }
    bf16_t* O; int ldc; const float* bias; int split_cols; size_t split_stride; float scale0; float wsc;
    __device__ __forceinline__ void operator()(const f32x4 (&acc)[2][2][4][2], const Unit& u, int wr, int wc, int fr, int fq, const PG8_LAS float* sb) const {
        const int row0 = u.pm * BM + wr * 64 + fr; int colt = u.pn * BM; bf16_t* base = O;
        float sc = 1.f; if (split_cols) { const int t = colt / split_cols; base += (size_t)t * split_stride; colt -= t * split_cols; if (t == 0) sc = scale0; }
        const int col0 = colt + wc * 32 + 8 * fq, bcol0 = u.pn * BM + wc * 32 + 8 * fq;
        f32x4 bv[2][2];
#pragma unroll
        for (int bj = 0; bj < 2; ++bj)
#pragma unroll
            for (int n = 0; n < 2; ++n) bv[bj][n] = bias ? *(const PG8_LAS f32x4*)(sb + wc * 32 + 8 * fq + bj * HALF + 4 * n) : (f32x4){0.f, 0.f, 0.f, 0.f};
        (void)bcol0;
#pragma unroll
        for (int ai = 0; ai < 2; ++ai)
#pragma unroll
            for (int m = 0; m < 4; ++m) { bf16_t* rowp = base + (size_t)(row0 + ai * HALF + m * 16) * ldc + col0;
#pragma unroll
                for (int bj = 0; bj < 2; ++bj) { f32x4 v0 = acc[ai][bj][m][0] * wsc + bv[bj][0], v1 = acc[ai][bj][m][1] * wsc + bv[bj][1];
                    if (ACT == 1) { f32x2 a = gelu_pk((f32x2){v0[0], v0[1]}), b = gelu_pk((f32x2){v0[2], v0[3]}), c = gelu_pk((f32x2){v1[0], v1[1]}), d = gelu_pk((f32x2){v1[2], v1[3]});
                        v0 = (f32x4){a.x, a.y, b.x, b.y}; v1 = (f32x4){c.x, c.y, d.x, d.y}; }
                    v0 = v0 * sc; v1 = v1 * sc; u32x4 w; w.x = cvt_pk_bf16(v0[0], v0[1]); w.y = cvt_pk_bf16(v0[2], v0[3]); w.z = cvt_pk_bf16(v1[0], v1[1]); w.w = cvt_pk_bf16(v1[2], v1[3]);
                    *(__attribute__((address_space(1))) u32x4*)(rowp + bj * HALF) = w; } }
    }
};
template <class Epi, class Sched, bool ALIGN_EPI = false, bool SP2 = false, bool GATHER = false, bool FP8 = false>
__device__ __forceinline__ void gemm_phase(PG8_LAS unsigned char* lds, const Gemm g, const Sched& S, const Epi& E) {
    int tid_ = threadIdx.x; asm volatile("" : "+v"(tid_));
    const int tid = tid_, wid = __builtin_amdgcn_readfirstlane(tid >> 6), lane = tid & 63, wr = wid >> 2, wc = wid & 3, fr = lane & 15, fq = lane >> 4;
    const int K = g.K, nt = K / BK;
    static_assert(!GATHER || SP2, "GATHER is wired into the SP2 loop only");
    unsigned voffA[2], voffB[2]; int gR[2]; unsigned gC[2];
#pragma unroll
    for (int i = 0; i < 2; ++i) { int R, C; stage_rc(tid * 16 + i * 8192, R, C); const int Rb = Epi::PERM ? ((R & ~31) + perm32(R & 31)) : R;
        voffA[i] = (unsigned)(R * K + C) * 2u; voffB[i] = (unsigned)(Rb * K + C) * 2u; gR[i] = R; gC[i] = (unsigned)C * 2u; }
    unsigned vA[2][2] = {{0u, 0u}, {0u, 0u}}; int tokN[2][2] = {{0, 0}, {0, 0}};
#define PG8_TOK(u_, h_, i_) (g.list ? (((u_).te * 256 + (h_) * 128 + gR[i_]) < (u_).cnt ? g.list[(size_t)(u_).e * LIST_STRIDE + (u_).te * 256 + (h_) * 128 + gR[i_]] : 0) : ((u_).pm * 256 + (h_) * 128 + gR[i_]))
    const size_t kstep = (size_t)(BK * 2);
    const size_t hstep = (size_t)HALF * K * 2;
    const size_t tstep = 2 * hstep;
    const unsigned ldsw = (unsigned)wid * 1024u;
    const int aoff = lds_byte(wr * 64 + fr, fq * 8), boff = lds_byte(wc * 32 + fr, fq * 8);
#define PG8_SA(b, h) (((b) * 2 + (h)) * HTB)
#define PG8_SB(b, h) ((4 + (b) * 2 + (h)) * HTB)
#define PG8_STAGE(bufoff, gbase, voff) do { _Pragma("unroll") for (int _i = 0; _i < 2; ++_i) \
        __builtin_amdgcn_global_load_lds((const unsigned*)((const char*)(gbase) + (voff)[_i]), (PG8_LAS unsigned*)(lds + (bufoff) + ldsw + _i * 8192), 16, 0, 0); } while (0)
#define PG8_GL16(gp, ldsoff) __builtin_amdgcn_global_load_lds((const unsigned*)(gp), (PG8_LAS unsigned*)(lds + (ldsoff)), 16, 0, 0)
#define PG8_STAGE_A(bufoff, gbase, h, NX) do { if constexpr (GATHER) { \
        PG8_GL16((const char*)(gbase) + vA[h][0], (bufoff) + ldsw); PG8_GL16((const char*)(gbase) + vA[h][1], (bufoff) + ldsw + 8192); } \
    else { PG8_STAGE(bufoff, (gbase) + (h) * hstep, voffA); } } while (0)
#define PG8_LDA(dst, b, h) do { _Pragma("unroll") for (int m = 0; m < 4; ++m) _Pragma("unroll") for (int k = 0; k < 2; ++k) dst[m][k] = *(const PG8_LAS bf16x8*)(lds + PG8_SA(b, h) + aoff + m * 2048 + k * 1024); } while (0)
#define PG8_LDB(dst, b, h) do { _Pragma("unroll") for (int n = 0; n < 2; ++n) _Pragma("unroll") for (int k = 0; k < 2; ++k) dst[n][k] = *(const PG8_LAS bf16x8*)(lds + PG8_SB(b, h) + boff + n * 2048 + k * 1024); } while (0)
#define PG8_CAT8(x0, x1) __builtin_shufflevector(__builtin_bit_cast(v4i_t, x0), __builtin_bit_cast(v4i_t, x1), 0, 1, 2, 3, 4, 5, 6, 7)
#define PG8_MMA(ai, bj, At, Bt) do { __builtin_amdgcn_s_setprio(1); if constexpr (FP8) { _Pragma("unroll") for (int m = 0; m < 4; ++m) _Pragma("unroll") for (int n = 0; n < 2; ++n) \
        acc[ai][bj][m][n] = __builtin_amdgcn_mfma_scale_f32_16x16x128_f8f6f4(PG8_CAT8(Bt[n][0], Bt[n][1]), PG8_CAT8(At[m][0], At[m][1]), acc[ai][bj][m][n], 0, 0, 0, 0x7F7F7F7F, 0, 0x7F7F7F7F); } \
    else { _Pragma("unroll") for (int m = 0; m < 4; ++m) _Pragma("unroll") for (int n = 0; n < 2; ++n) _Pragma("unroll") for (int k = 0; k < 2; ++k) \
        acc[ai][bj][m][n] = __builtin_amdgcn_mfma_f32_16x16x32_bf16(Bt[n][k], At[m][k], acc[ai][bj][m][n], 0, 0, 0); } __builtin_amdgcn_s_setprio(0); } while (0)
#define PG8_WAIT_V(n) asm volatile("s_waitcnt vmcnt(" #n ")" ::: "memory")
#define PG8_WAIT_L(n) asm volatile("s_waitcnt lgkmcnt(" #n ")" ::: "memory")
#define PG8_BAR __builtin_amdgcn_s_barrier()
#define PG8_SCHED __builtin_amdgcn_sched_barrier(0)
    Unit cur, nxt; int ui = 0;
    PG8_LAS int* utab = (PG8_LAS int*)(lds + g.sb_off + 2 * 3072);
    __syncthreads();
    if (tid < 32) { Unit u_; u_.pm = u_.pn = u_.e = u_.te = u_.cnt = 0; const bool ok_ = S.next_lane(tid, u_); PG8_LAS int* r_ = utab + tid * 8; r_[0] = ok_ ? 1 : 0; r_[1] = u_.pm; r_[2] = u_.pn; r_[3] = u_.e; r_[4] = u_.te; r_[5] = u_.cnt; }
    __syncthreads();
#define PG8_UNIT(i_, u_) ((i_) < 32 ? ((__builtin_amdgcn_readfirstlane(utab[(i_) * 8]) != 0) ? ((u_).pm = __builtin_amdgcn_readfirstlane(utab[(i_) * 8 + 1]), (u_).pn = __builtin_amdgcn_readfirstlane(utab[(i_) * 8 + 2]), (u_).e = __builtin_amdgcn_readfirstlane(utab[(i_) * 8 + 3]), \
        (u_).te = __builtin_amdgcn_readfirstlane(utab[(i_) * 8 + 4]), (u_).cnt = __builtin_amdgcn_readfirstlane(utab[(i_) * 8 + 5]), true) : false) : S.next((i_), (u_)))
    if (!PG8_UNIT(0, cur)) return;
    f32x4 acc[2][2][4][2];
#pragma unroll
    for (int a = 0; a < 2; ++a)
#pragma unroll
        for (int b = 0; b < 2; ++b)
#pragma unroll
            for (int m = 0; m < 4; ++m)
#pragma unroll
                for (int n = 0; n < 2; ++n) acc[a][b][m][n] = (f32x4){0.f, 0.f, 0.f, 0.f};
    bf16x8 At[4][2], B0[2][2], B1[2][2];
    const char* cA = (const char*)g.A + (GATHER ? (size_t)0 : (size_t)cur.pm * tstep); const char* cB = (const char*)g.Bt + (size_t)cur.pn * tstep + (size_t)cur.e * g.bstride;
    if constexpr (GATHER) {
#pragma unroll
        for (int h = 0; h < 2; ++h)
#pragma unroll
            for (int i = 0; i < 2; ++i) vA[h][i] = (unsigned)PG8_TOK(cur, h, i) * (unsigned)(K * 2) + gC[i];
    }
    S.a_ready(cur);
    if constexpr (SP2) {
        PG8_STAGE(PG8_SB(0, 0), cB, voffB); PG8_STAGE(PG8_SB(0, 1), cB + hstep, voffB); PG8_STAGE_A(PG8_SA(0, 0), cA, 0, false); PG8_STAGE_A(PG8_SA(0, 1), cA, 1, false);
        if (wr == 1) PG8_BAR;
        PG8_WAIT_V(2); PG8_BAR;
        PG8_STAGE(PG8_SB(1, 0), cB + kstep, voffB); PG8_STAGE_A(PG8_SA(1, 0), cA + kstep, 0, false); PG8_STAGE(PG8_SB(1, 1), cB + hstep + kstep, voffB);
        PG8_WAIT_V(6); PG8_BAR;
    } else {
        PG8_STAGE(PG8_SB(0, 0), cB, voffB); PG8_STAGE(PG8_SA(0, 0), cA, voffA); PG8_STAGE(PG8_SB(0, 1), cB + hstep, voffB); PG8_STAGE(PG8_SA(0, 1), cA + hstep, voffA);
        if (wr == 1) PG8_BAR;
        PG8_WAIT_V(4); PG8_BAR;
        PG8_STAGE(PG8_SB(1, 0), cB + kstep, voffB); PG8_STAGE(PG8_SA(1, 0), cA + kstep, voffA); PG8_STAGE(PG8_SB(1, 1), cB + hstep + kstep, voffB);
        PG8_WAIT_V(6); PG8_BAR;
    }
    for (;;) {
        const bool has_next = PG8_UNIT(ui + 1, nxt);
        const char* nA = (has_next && !GATHER) ? (const char*)g.A + (size_t)nxt.pm * tstep : cA; const char* nB = has_next ? (const char*)g.Bt + (size_t)nxt.pn * tstep + (size_t)nxt.e * g.bstride : cB;

        if constexpr (Epi::NSB > 0) {
#pragma unroll
            for (int k = 0; k < Epi::NSB; ++k) if (wid == k) { const void* src_ = E.sb_src(cur, k, lane); if (src_) PG8_GL16(src_, g.sb_off + (ui & 1) * 3072 + k * 1024); } }
        if constexpr (GATHER) { if (has_next) {
#pragma unroll
            for (int h = 0; h < 2; ++h)
#pragma unroll
                for (int i = 0; i < 2; ++i) tokN[h][i] = PG8_TOK(nxt, h, i); } }
#pragma nounroll
        for (int t = 0; t < nt; t += 2) {
            const bool last = (t == nt - 2);
            const char* a1 = cA + (size_t)(t + 1) * kstep;
            const char* a2 = last ? nA : cA + (size_t)(t + 2) * kstep; const char* b2 = last ? nB : cB + (size_t)(t + 2) * kstep;
            const char* a3 = a2 + kstep; const char* b3 = b2 + kstep;
            if (last && has_next) S.a_ready(nxt);
            if constexpr (SP2) {
            PG8_LDB(B0, 0, 0); PG8_LDB(B1, 0, 1); PG8_SCHED; PG8_LDA(At, 0, 0); PG8_STAGE_A(PG8_SA(1, 1), a1, 1, false);
            if constexpr (GATHER) { if (last && has_next) {
#pragma unroll
                for (int h = 0; h < 2; ++h)
#pragma unroll
                    for (int i = 0; i < 2; ++i) vA[h][i] = (unsigned)tokN[h][i] * (unsigned)(K * 2) + gC[i]; } }
            PG8_WAIT_V(8); PG8_WAIT_L(0); PG8_BAR; PG8_MMA(0, 0, At, B0); PG8_MMA(0, 1, At, B1); PG8_BAR; PG8_SCHED;
            PG8_LDA(At, 0, 1); PG8_STAGE(PG8_SB(0, 0), b2, voffB); PG8_STAGE(PG8_SB(0, 1), b2 + hstep, voffB); PG8_STAGE_A(PG8_SA(0, 0), a2, 0, last);
            PG8_WAIT_V(8); PG8_WAIT_L(0); PG8_BAR; PG8_MMA(1, 0, At, B0); PG8_MMA(1, 1, At, B1); PG8_BAR; PG8_SCHED;
            PG8_LDB(B0, 1, 0); PG8_LDB(B1, 1, 1); PG8_SCHED; PG8_LDA(At, 1, 0); PG8_STAGE_A(PG8_SA(0, 1), a2, 1, last);
            PG8_WAIT_V(8); PG8_WAIT_L(0); PG8_BAR; PG8_MMA(0, 0, At, B0); PG8_MMA(0, 1, At, B1); PG8_BAR; PG8_SCHED;
            PG8_LDA(At, 1, 1); PG8_STAGE(PG8_SB(1, 0), b3, voffB); PG8_STAGE(PG8_SB(1, 1), b3 + hstep, voffB); PG8_STAGE_A(PG8_SA(1, 0), a3, 0, last);
            PG8_WAIT_V(8); PG8_WAIT_L(0); PG8_BAR; PG8_MMA(1, 0, At, B0); PG8_MMA(1, 1, At, B1); PG8_BAR; PG8_SCHED;
            } else {
            PG8_LDB(B0, 0, 0); PG8_SCHED; PG8_LDA(At, 0, 0); PG8_STAGE(PG8_SA(1, 1), a1 + hstep, voffA);
            PG8_WAIT_L(8); PG8_BAR; PG8_WAIT_L(0); PG8_MMA(0, 0, At, B0); PG8_BAR; PG8_SCHED;
            PG8_LDB(B1, 0, 1); PG8_STAGE(PG8_SB(0, 0), b2, voffB);
            PG8_BAR; PG8_WAIT_L(0); PG8_MMA(0, 1, At, B1); PG8_BAR;
            PG8_LDA(At, 0, 1); PG8_STAGE(PG8_SA(0, 0), a2, voffA);
            PG8_BAR; PG8_WAIT_L(0); PG8_MMA(1, 0, At, B0); PG8_BAR; PG8_SCHED;
            PG8_STAGE(PG8_SB(0, 1), b2 + hstep, voffB);
            PG8_WAIT_V(6); PG8_BAR; PG8_MMA(1, 1, At, B1); PG8_BAR;
            PG8_LDB(B0, 1, 0); PG8_SCHED; PG8_LDA(At, 1, 0); PG8_STAGE(PG8_SA(0, 1), a2 + hstep, voffA);
            PG8_WAIT_L(8); PG8_BAR; PG8_WAIT_L(0); PG8_MMA(0, 0, At, B0); PG8_BAR; PG8_SCHED;
            PG8_LDB(B1, 1, 1); PG8_STAGE(PG8_SB(1, 0), b3, voffB);
            PG8_BAR; PG8_WAIT_L(0); PG8_MMA(0, 1, At, B1); PG8_BAR;
            PG8_LDA(At, 1, 1); PG8_STAGE(PG8_SA(1, 0), a3, voffA);
            PG8_BAR; PG8_WAIT_L(0); PG8_MMA(1, 0, At, B0); PG8_BAR; PG8_SCHED;
            PG8_STAGE(PG8_SB(1, 1), b3 + hstep, voffB);
            PG8_WAIT_V(6); PG8_BAR; PG8_MMA(1, 1, At, B1); PG8_BAR;
            }
        }
        if constexpr (ALIGN_EPI) { if (wr == 0) PG8_BAR; }
        if constexpr (!Epi::AFTER_DRAIN) { E(acc, cur, wr, wc, fr, fq, (const PG8_LAS float*)(lds + g.sb_off + (ui & 1) * 3072)); S.done(cur); }
        if (!has_next) break;
#pragma unroll
        for (int a = 0; a < 2; ++a)
#pragma unroll
            for (int b = 0; b < 2; ++b)
#pragma unroll
                for (int m = 0; m < 4; ++m)
#pragma unroll
                    for (int n = 0; n < 2; ++n) acc[a][b][m][n] = (f32x4){0.f, 0.f, 0.f, 0.f};
        cur = nxt; cA = nA; cB = nB; ++ui;

        if constexpr (ALIGN_EPI) { if (wr == 1) PG8_BAR; }
    }
    PG8_WAIT_V(0);
    if constexpr (!ALIGN_EPI) { if (wr == 0) PG8_BAR; }
    PG8_BAR;
    if constexpr (Epi::AFTER_DRAIN) { E.fused(acc, cur, wr, wc, fr, fq, lds, wid, lane); S.done(cur); }
#undef PG8_SA
#undef PG8_SB
#undef PG8_STAGE
#undef PG8_LDA
#undef PG8_STAGE_A
#undef PG8_GL16
#undef PG8_TOK
#undef PG8_UNIT
#undef PG8_LDB
#undef PG8_MMA
#undef PG8_CAT8
#undef PG8_WAIT_V
#undef PG8_WAIT_L
#undef PG8_BAR
#undef PG8_SCHED
}

struct EpiZ {
    static constexpr bool PERM = false, AFTER_DRAIN = false; static constexpr int NSB = 0;
    float* Z; const float* xres; const float* bias; int ldc; float alpha; float wsc;
    __device__ __forceinline__ void operator()(const f32x4 (&acc)[2][2][4][2], const Unit& u, int wr, int wc, int fr, int fq, const PG8_LAS float*) const {
        const int row0 = u.pm * BM + wr * 64 + fr, col0 = u.pn * BM + wc * 32 + 4 * fq;
        f32x4 bv[2][2];
#pragma unroll
        for (int bj = 0; bj < 2; ++bj)
#pragma unroll
            for (int n = 0; n < 2; ++n) bv[bj][n] = bias ? *(const f32x4*)(bias + col0 + bj * HALF + n * 16) : (f32x4){0.f, 0.f, 0.f, 0.f};
#pragma unroll
        for (int ai = 0; ai < 2; ++ai)
#pragma unroll
            for (int mp = 0; mp < 2; ++mp) {
                f32x4 xr[2][2][2];
#pragma unroll
                for (int mm = 0; mm < 2; ++mm) { const size_t off = (size_t)(row0 + ai * HALF + (2 * mp + mm) * 16) * ldc + col0;
#pragma unroll
                    for (int bj = 0; bj < 2; ++bj)
#pragma unroll
                        for (int n = 0; n < 2; ++n) xr[mm][bj][n] = *(const __attribute__((address_space(1))) f32x4*)(xres + off + bj * HALF + n * 16); }
#pragma unroll
                for (int mm = 0; mm < 2; ++mm) { const int m = 2 * mp + mm; const size_t off = (size_t)(row0 + ai * HALF + m * 16) * ldc + col0;
#pragma unroll
                    for (int bj = 0; bj < 2; ++bj)
#pragma unroll
                        for (int n = 0; n < 2; ++n) *(__attribute__((address_space(1))) f32x4*)(Z + off + bj * HALF + n * 16) = bf16r4(acc[ai][bj][m][n] * wsc + bv[bj][n] + xr[mm][bj][n] * alpha); }
                asm volatile("" ::: "memory");
            }
    }
};
struct EpiZ16 {
    static constexpr bool PERM = true, AFTER_DRAIN = false; static constexpr int NSB = 1;
    bf16_t* Z; const bf16_t* xres; const float* bias; int ldc; float alpha; float wsc;
    __device__ __forceinline__ const void* sb_src(const Unit& u, int, int lane) const { return bias ? (const void*)(bias + u.pn * BM + lane * 4) : nullptr; }
    __device__ __forceinline__ void operator()(const f32x4 (&acc)[2][2][4][2], const Unit& u, int wr, int wc, int fr, int fq, const PG8_LAS float* sb) const {
        const int row0 = u.pm * BM + wr * 64 + fr, col0 = u.pn * BM + wc * 32 + 8 * fq;
        f32x4 bv[2][2];
#pragma unroll
        for (int bj = 0; bj < 2; ++bj)
#pragma unroll
            for (int n = 0; n < 2; ++n) bv[bj][n] = bias ? *(const PG8_LAS f32x4*)(sb + wc * 32 + 8 * fq + bj * HALF + 4 * n) : (f32x4){0.f, 0.f, 0.f, 0.f};
#pragma unroll
        for (int ai = 0; ai < 2; ++ai) {
            u32x4 xr[4][2];
#pragma unroll
            for (int m = 0; m < 4; ++m)
#pragma unroll
                for (int bj = 0; bj < 2; ++bj) xr[m][bj] = *(const __attribute__((address_space(1))) u32x4*)(xres + (size_t)(row0 + ai * HALF + m * 16) * ldc + col0 + bj * HALF);
#pragma unroll
            for (int m = 0; m < 4; ++m)
#pragma unroll
                for (int bj = 0; bj < 2; ++bj) { const u32x4 x = xr[m][bj];
                    const f32x4 x0 = {__builtin_bit_cast(float, x.x << 16), __builtin_bit_cast(float, x.x & 0xffff0000u), __builtin_bit_cast(float, x.y << 16), __builtin_bit_cast(float, x.y & 0xffff0000u)};
                    const f32x4 x1 = {__builtin_bit_cast(float, x.z << 16), __builtin_bit_cast(float, x.z & 0xffff0000u), __builtin_bit_cast(float, x.w << 16), __builtin_bit_cast(float, x.w & 0xffff0000u)};
                    const f32x4 v0 = acc[ai][bj][m][0] * wsc + bv[bj][0] + x0 * alpha, v1 = acc[ai][bj][m][1] * wsc + bv[bj][1] + x1 * alpha;
                    u32x4 w; w.x = cvt_pk_bf16(v0[0], v0[1]); w.y = cvt_pk_bf16(v0[2], v0[3]); w.z = cvt_pk_bf16(v1[0], v1[1]); w.w = cvt_pk_bf16(v1[2], v1[3]);
                    *(__attribute__((address_space(1))) u32x4*)(Z + (size_t)(row0 + ai * HALF + m * 16) * ldc + col0 + bj * HALF) = w; }
        }
    }
};
__device__ __forceinline__ float swiglu1(float g, float u) {
    g = fminf(g, 7.0f); u = fminf(fmaxf(u, -7.0f), 7.0f);
    const float s = __builtin_amdgcn_rcpf(1.0f + __builtin_amdgcn_exp2f(g * (-1.702f * 1.4426950408889634f)));
    const float a_ = (u + 1.0f) * (g * s);
    return (FP8_EMU & 2) ? e4m3r(a_) : a_;
}
__device__ __forceinline__ f32x2 swiglu2s(f32x2 g, f32x2 u) {
    g.x = fminf(g.x, 7.0f); g.y = fminf(g.y, 7.0f);
    u.x = __builtin_amdgcn_fmed3f(u.x, -7.0f, 7.0f); u.y = __builtin_amdgcn_fmed3f(u.y, -7.0f, 7.0f);
    const f32x2 t = g * (-1.702f * 1.4426950408889634f);
    f32x2 d; d.x = __builtin_amdgcn_exp2f(t.x); d.y = __builtin_amdgcn_exp2f(t.y);
    d = d + 1.0f;
    f32x2 sg; sg.x = __builtin_amdgcn_rcpf(d.x); sg.y = __builtin_amdgcn_rcpf(d.y);
    const f32x2 up = u * ACT_SCALE + ACT_SCALE;
    return up * (g * sg);
}
struct EpiSwiglu {
    static constexpr bool PERM = true, AFTER_DRAIN = false; static constexpr int NSB = 1;
    __device__ __forceinline__ const void* sb_src(const Unit& u, int, int lane) const {
        return (const void*)(bgu + (size_t)u.e * 2048 + (lane >> 5) * 1024 + u.pn * HALF + (lane & 31) * 4); }
    bf16_t* ACT; const float* bgu; float wsc;
    __device__ __forceinline__ void operator()(const f32x4 (&acc)[2][2][4][2], const Unit& u, int wr, int wc, int fr, int fq, const PG8_LAS float* sb) const {
        const int row0 = u.pm * BM + wr * 64 + fr, j0 = u.pn * HALF + wc * 32 + 8 * fq;
        const PG8_LAS float* bg = sb + wc * 32 + 8 * fq;
        const f32x4 g0 = *(const PG8_LAS f32x4*)bg, g1 = *(const PG8_LAS f32x4*)(bg + 4), u0 = *(const PG8_LAS f32x4*)(bg + 128), u1 = *(const PG8_LAS f32x4*)(bg + 132);
#pragma unroll
        for (int ai = 0; ai < 2; ++ai)
#pragma unroll
            for (int m = 0; m < 4; ++m) { unsigned char* rowp = (unsigned char*)ACT + (size_t)(row0 + ai * HALF + m * 16) * 1024 + j0;
                const f32x4 ga = acc[ai][0][m][0] * wsc + g0, gb = acc[ai][0][m][1] * wsc + g1, ua = acc[ai][1][m][0] * wsc + u0, ub = acc[ai][1][m][1] * wsc + u1;
                const f32x2 a0 = swiglu2s((f32x2){ga[0], ga[1]}, (f32x2){ua[0], ua[1]}), a1 = swiglu2s((f32x2){ga[2], ga[3]}, (f32x2){ua[2], ua[3]});
                const f32x2 a2 = swiglu2s((f32x2){gb[0], gb[1]}, (f32x2){ub[0], ub[1]}), a3 = swiglu2s((f32x2){gb[2], gb[3]}, (f32x2){ub[2], ub[3]});
                v2u w; w.x = pk4_fp8(a0.x, a0.y, a1.x, a1.y); w.y = pk4_fp8(a2.x, a2.y, a3.x, a3.y);
                *(__attribute__((address_space(1))) v2u*)rowp = w; }
    }
};
struct EpiDown {
    static constexpr bool PERM = true, AFTER_DRAIN = false; static constexpr int NSB = 3;
    __device__ __forceinline__ const void* sb_src(const Unit& u, int k, int lane) const {
        return k == 0 ? (const void*)(bd + (size_t)u.e * 1024 + u.pn * BM + lane * 4) : k == 1 ? (const void*)(sgate + (size_t)u.e * LIST_STRIDE + u.te * BM + lane * 4)
                                                                                                   : (const void*)(listk + (size_t)u.e * LIST_STRIDE + u.te * BM + lane * 4); }
    const int* listk;
    bf16_t* Y; const float* bd; const float* sgate; float wsc;
    __device__ __forceinline__ void operator()(const f32x4 (&acc)[2][2][4][2], const Unit& u, int wr, int wc, int fr, int fq, const PG8_LAS float* sb) const {
        const int col0 = u.pn * BM + wc * 32 + 8 * fq;
        f32x4 bv[2][2];
#pragma unroll
        for (int bj = 0; bj < 2; ++bj)
#pragma unroll
            for (int n = 0; n < 2; ++n) bv[bj][n] = *(const PG8_LAS f32x4*)(sb + wc * 32 + 8 * fq + bj * HALF + 4 * n);
        float gts[2][4];
#pragma unroll
        for (int ai = 0; ai < 2; ++ai)
#pragma unroll
            for (int m = 0; m < 4; ++m) gts[ai][m] = sb[256 + wr * 64 + fr + ai * HALF + m * 16];
        int dst[2][4];
#pragma unroll
        for (int ai = 0; ai < 2; ++ai)
#pragma unroll
            for (int m = 0; m < 4; ++m) { const int rl = wr * 64 + fr + ai * HALF + m * 16; dst[ai][m] = (u.te * BM + rl) < u.cnt ? ((const PG8_LAS int*)sb)[512 + rl] : -1; }
#pragma unroll
        for (int ai = 0; ai < 2; ++ai)
#pragma unroll
            for (int m = 0; m < 4; ++m) { if (dst[ai][m] < 0) continue; const float gt = gts[ai][m] * Y_SCALE; unsigned char* rowp = (unsigned char*)Y + (size_t)dst[ai][m] * 1024 + col0;
#pragma unroll
                for (int bj = 0; bj < 2; ++bj) { const f32x4 v0 = (acc[ai][bj][m][0] * wsc + bv[bj][0]) * gt, v1 = (acc[ai][bj][m][1] * wsc + bv[bj][1]) * gt;
                    v2u w; w.x = pk4_fp8(v0[0], v0[1], v0[2], v0[3]); w.y = pk4_fp8(v1[0], v1[1], v1[2], v1[3]);
                    *(__attribute__((address_space(1))) v2u*)(rowp + bj * HALF) = w; } }
    }
};
struct MoeOrder {
    StaticOrder so; const PG8_LAS int* t_e; const PG8_LAS int* t_te; const PG8_LAS int* t_cnt;
    __device__ void init(int nmt, int N, int G_, int c_, const PG8_LAS int* te_, const PG8_LAS int* tte_, const PG8_LAS int* tc_) { so.init(nmt * BM, N, G_, c_); t_e = te_; t_te = tte_; t_cnt = tc_; }
    __device__ bool next(int i, Unit& u) const { if (!so.next(i, u)) return false;
        u.e = __builtin_amdgcn_readfirstlane(t_e[u.pm]); u.te = __builtin_amdgcn_readfirstlane(t_te[u.pm]); u.cnt = __builtin_amdgcn_readfirstlane(t_cnt[u.e]); return true; }
    __device__ bool next_lane(int i, Unit& u) const { if (!so.next(i, u)) return false; u.e = t_e[u.pm]; u.te = t_te[u.pm]; u.cnt = t_cnt[u.e]; return true; }
    __device__ __forceinline__ void a_ready(const Unit&) const {}
    __device__ __forceinline__ void done(const Unit&) const {}
};
}

template <int CTRL> __device__ __forceinline__ float dpp_f(float v) { return __builtin_bit_cast(float, __builtin_amdgcn_update_dpp(0, __builtin_bit_cast(int, v), CTRL, 0xF, 0xF, true)); }
template <int CTRL> __device__ __forceinline__ int dpp_i(int v) { return __builtin_amdgcn_update_dpp(0, v, CTRL, 0xF, 0xF, true); }
__device__ __forceinline__ float g16_max(float v, int) {
    v = fmaxf(v, dpp_f<0xB1>(v)); v = fmaxf(v, dpp_f<0x4E>(v)); v = fmaxf(v, dpp_f<0x141>(v)); v = fmaxf(v, dpp_f<0x140>(v)); return v;
}
__device__ __forceinline__ int g16_min(int v, int) {
    int t = dpp_i<0xB1>(v); v = t < v ? t : v; t = dpp_i<0x4E>(v); v = t < v ? t : v; t = dpp_i<0x141>(v); v = t < v ? t : v; t = dpp_i<0x140>(v); v = t < v ? t : v; return v;
}
__device__ __forceinline__ void ln1_router_phase(Frame& F, const bf16* Z, const float* g, const float* b, const bf16* Wr2, const float* br,
                                                 bf16* X1, unsigned char* X18, int* TOPE, float* TOPG, int* POS, unsigned* CNT, int* LIST, float* LGATE, int* LISTK, int ln_only = 0) {
    const int lane = F.lane, tk = lane & 15, kg = lane >> 4;
    LAS unsigned* hist = (LAS unsigned*)F.lds;
    const int nrounds = (T + F.NGW * 16 - 1) / (F.NGW * 16);
    for (int rd_ = 0; rd_ < nrounds; ++rd_) {
        const int t0 = (rd_ * F.NGW + F.gw) * 16; const bool live = t0 < T;
        if (F.tid < 32) hist[F.tid] = 0u;
        __syncthreads();
        int ex_r[4]; float gt_r[4]; unsigned lp_r[4];
        if (live) {
        if (ln_only != 3)
        {
            float gv[2][8], bv[2][8];
#pragma unroll
            for (int j = 0; j < 2; ++j)
#pragma unroll
                for (int e = 0; e < 8; ++e) { gv[j][e] = g[8 * (lane + 64 * j) + e]; bv[j][e] = b[8 * (lane + 64 * j) + e]; }
#pragma unroll 4
            for (int tt = 0; tt < 16; ++tt) {
                const size_t m = (size_t)(t0 + tt);
                const GAS v4u* zr = (const GAS v4u*)(Z + m * D) + lane;
                float v[2][8]; unpack8(zr[0], v[0]); unpack8(zr[64], v[1]);
                float s = 0.f;
#pragma unroll
                for (int j = 0; j < 2; ++j)
#pragma unroll
                    for (int e = 0; e < 8; ++e) s += v[j][e];
                const float mean = wave_sum(s, lane) * (1.f / D); float s2 = 0.f;
#pragma unroll
                for (int j = 0; j < 2; ++j)
#pragma unroll
                    for (int e = 0; e < 8; ++e) { v[j][e] -= mean; s2 += v[j][e] * v[j][e]; }
                const float rstd = 1.0f / sqrtf(wave_sum(s2, lane) * (1.f / D) + LN_EPS);
#pragma unroll
                for (int j = 0; j < 2; ++j) {
#pragma unroll
                    for (int e = 0; e < 8; ++e) v[j][e] = v[j][e] * rstd * gv[j][e] + bv[j][e];
                    ((GAS v4u*)(X1 + m * D))[lane + 64 * j] = pack8(v[j]);
                    v2u w8; w8.x = pk4_fp8(v[j][0], v[j][1], v[j][2], v[j][3]); w8.y = pk4_fp8(v[j][4], v[j][5], v[j][6], v[j][7]);
                    ((GAS v2u*)(X18 + m * D))[lane + 64 * j] = w8; }
            }
        }
        asm volatile("s_waitcnt vmcnt(0)" ::: "memory");
        f32x4 a0 = {0.f, 0.f, 0.f, 0.f}, a1 = {0.f, 0.f, 0.f, 0.f};
        if (ln_only != 1) {
        const GAS bf16* xrow = (const GAS bf16*)(X1 + (size_t)(t0 + tk) * D + 8 * kg);
        const GAS bf16* wh = (const GAS bf16*)(Wr2 + (size_t)tk * D + 8 * kg); const GAS bf16* wl = wh + (size_t)NEXP * D;
#pragma unroll 4
        for (int ks = 0; ks < 32; ++ks) {
            const bf16x8 xh = *(const GAS bf16x8*)(xrow + 32 * ks);
            const bf16x8 bh0 = *(const GAS bf16x8*)(wh + 32 * ks), bh1 = *(const GAS bf16x8*)(wh + 16 * D + 32 * ks), bl0 = *(const GAS bf16x8*)(wl + 32 * ks), bl1 = *(const GAS bf16x8*)(wl + 16 * D + 32 * ks);
            a0 = __builtin_amdgcn_mfma_f32_16x16x32_bf16(xh, bh0, a0, 0, 0, 0); a1 = __builtin_amdgcn_mfma_f32_16x16x32_bf16(xh, bh1, a1, 0, 0, 0);
            a0 = __builtin_amdgcn_mfma_f32_16x16x32_bf16(xh, bl0, a0, 0, 0, 0); a1 = __builtin_amdgcn_mfma_f32_16x16x32_bf16(xh, bl1, a1, 0, 0, 0);
        }
        }
        const float b0 = br[tk], b1 = br[16 + tk];
        if (ln_only == 1) { ex_r[0] = ex_r[1] = ex_r[2] = ex_r[3] = 0; }
        else if (ln_only == 2) { if (a0[0] + a1[1] + a0[2] + a1[3] == 1.2345f) TOPG[t0] = a0[1]; }
        else
#pragma unroll
        for (int r = 0; r < 4; ++r) {
            float v0 = a0[r] + b0, v1 = a1[r] + b1;
            float tv[4]; int ti[4];
#pragma unroll
            for (int rd = 0; rd < 4; ++rd) {
                const float gm = g16_max(fmaxf(v0, v1), lane);
                const int cand = (v0 == gm) ? tk : ((v1 == gm) ? 16 + tk : 64);
                const int gi = g16_min(cand, lane);
                tv[rd] = gm; ti[rd] = gi; if (gi == tk) v0 = -INFINITY; if (gi == 16 + tk) v1 = -INFINITY;
            }
            const float e1 = __expf(tv[1] - tv[0]), e2 = __expf(tv[2] - tv[0]), e3 = __expf(tv[3] - tv[0]);
            const float inv = 1.0f / (1.0f + e1 + e2 + e3);
            ex_r[r] = tk == 0 ? ti[0] : tk == 1 ? ti[1] : tk == 2 ? ti[2] : ti[3];
            gt_r[r] = (tk == 0 ? 1.0f : tk == 1 ? e1 : tk == 2 ? e2 : e3) * inv;
            lp_r[r] = 0u;
            if (tk < 4) lp_r[r] = __hip_atomic_fetch_add(hist + ex_r[r], 1u, __ATOMIC_RELAXED, __HIP_MEMORY_SCOPE_WORKGROUP);
        }
        }
        __syncthreads();
        if (F.tid < 32) { const unsigned c = hist[F.tid]; hist[32 + F.tid] = c ? atomicAdd(CNT + F.tid * CNT_STRIDE, c) : 0u; }
        __syncthreads();
        if (live && tk < 4 && ln_only != 1) {
#pragma unroll
            for (int r = 0; r < 4; ++r) { const size_t a = (size_t)(t0 + 4 * kg + r) * 4 + tk;
                const int pos = (int)(hist[32 + ex_r[r]] + lp_r[r]);
                TOPE[a] = ex_r[r]; TOPG[a] = gt_r[r]; POS[a] = pos; LIST[(size_t)ex_r[r] * T + pos] = t0 + 4 * kg + r; LGATE[(size_t)ex_r[r] * T + pos] = gt_r[r]; LISTK[(size_t)ex_r[r] * T + pos] = (t0 + 4 * kg + r) * 4 + tk; }
        }
        __syncthreads();
    }
}

__device__ __forceinline__ void moe_tables(Frame& F, const unsigned* CNT) {
    const int lane = F.lane;
    LAS int* pst = (LAS int*)(F.lds + LT_PSTART); LAS int* pcn = (LAS int*)(F.lds + LT_CNT); LAS int* pen = (LAS int*)(F.lds + LT_SB);
    __syncthreads();
    if (F.wave == 0) {
        const unsigned c = lane < 32 ? __hip_atomic_load(CNT + (lane & 31) * CNT_STRIDE, __ATOMIC_RELAXED, __HIP_MEMORY_SCOPE_AGENT) : 0u;
        const int padded = (int)((c + 255u) & ~255u);
        int incl = padded;
#pragma unroll
        for (int o = 1; o < 32; o <<= 1) { const int t = shfl_i(incl, (lane - o) & 63); if ((lane & 31) >= o) incl += t; }
        if (lane < 32) { pst[lane] = incl - padded; pcn[lane] = (int)c; pen[lane] = incl; }
        if (lane == 31) ((LAS int*)(F.lds + LT_NMT))[0] = incl >> 8;
    }
    __syncthreads();
    for (int mt = F.tid; mt < MAXMT; mt += NTHREADS) {
        int ee = 0;
#pragma unroll 8
        for (int q = 0; q < 32; ++q) ee += (pen[q] <= mt * 256) ? 1 : 0;
        ee = ee < 31 ? ee : 31;
        ((LAS int*)(F.lds + LT_E))[mt] = ee; ((LAS int*)(F.lds + LT_TE))[mt] = mt - (pst[ee] >> 8);
    }
    __syncthreads();
}

__device__ __forceinline__ void ln2_phase(Frame& F, const bf16* __restrict__ X1, const bf16* __restrict__ Y, const int* __restrict__ TOPE, const int* __restrict__ POS, const float* __restrict__ g, const float* __restrict__ b,
                                          bf16* __restrict__ XR, float* __restrict__ OUT, unsigned char* __restrict__ XB, bool last_layer) {
    const int lane = F.lane;
    float gv[2][8], bv[2][8];
#pragma unroll
    for (int j = 0; j < 2; ++j)
#pragma unroll
        for (int e = 0; e < 8; ++e) { gv[j][e] = g[8 * (lane + 64 * j) + e]; bv[j][e] = b[8 * (lane + 64 * j) + e]; }
    for (int tok0 = F.gw; tok0 < T; tok0 += 2 * F.NGW) {
        float v[2][2][8]; v2u yw[2][4][2];
#pragma unroll
        for (int q = 0; q < 2; ++q) { const int tok = tok0 + q * F.NGW; if (tok < T) {
            const GAS v4u* xr = (const GAS v4u*)(X1 + (size_t)tok * D) + lane; const v4u x0 = xr[0], x1 = xr[64];
#pragma unroll
            for (int r = 0; r < 4; ++r) { const GAS v2u* yr = (const GAS v2u*)((const unsigned char*)Y + (size_t)(tok * 4 + r) * D) + lane; yw[q][r][0] = __builtin_nontemporal_load(yr); yw[q][r][1] = __builtin_nontemporal_load(yr + 64); }
            unpack8(x0, v[q][0]); unpack8(x1, v[q][1]); } }
#pragma unroll
        for (int q = 0; q < 2; ++q) { const int tok = tok0 + q * F.NGW; if (tok < T) {
#pragma unroll
            for (int j = 0; j < 2; ++j)
#pragma unroll
                for (int e = 0; e < 8; ++e) v[q][j][e] *= DN_ALPHA;
#pragma unroll
            for (int r = 0; r < 4; ++r)
#pragma unroll
                for (int j = 0; j < 2; ++j) { const v2u w = yw[q][r][j];
                    const f32x2_t a0 = __builtin_amdgcn_cvt_pk_f32_fp8((int)w.x, false), a1 = __builtin_amdgcn_cvt_pk_f32_fp8((int)w.x, true), a2 = __builtin_amdgcn_cvt_pk_f32_fp8((int)w.y, false), a3 = __builtin_amdgcn_cvt_pk_f32_fp8((int)w.y, true);
                    v[q][j][0] += a0.x * (1.0f / Y_SCALE); v[q][j][1] += a0.y * (1.0f / Y_SCALE); v[q][j][2] += a1.x * (1.0f / Y_SCALE); v[q][j][3] += a1.y * (1.0f / Y_SCALE);
                    v[q][j][4] += a2.x * (1.0f / Y_SCALE); v[q][j][5] += a2.y * (1.0f / Y_SCALE); v[q][j][6] += a3.x * (1.0f / Y_SCALE); v[q][j][7] += a3.y * (1.0f / Y_SCALE); }
            float s = 0.f;
#pragma unroll
            for (int j = 0; j < 2; ++j)
#pragma unroll
                for (int e = 0; e < 8; ++e) s += v[q][j][e];
            const float mean = wave_sum(s, lane) * (1.f / D); float s2 = 0.f;
#pragma unroll
            for (int j = 0; j < 2; ++j)
#pragma unroll
                for (int e = 0; e < 8; ++e) { v[q][j][e] -= mean; s2 += v[q][j][e] * v[q][j][e]; }
            const float rstd = 1.0f / sqrtf(wave_sum(s2, lane) * (1.f / D) + LN_EPS);
#pragma unroll
            for (int j = 0; j < 2; ++j) {
#pragma unroll
                for (int e = 0; e < 8; ++e) v[q][j][e] = v[q][j][e] * rstd * gv[j][e] + bv[j][e];
                if (last_layer) { GAS f32x4* of = (GAS f32x4*)(OUT + (size_t)tok * D + 8 * (lane + 64 * j));
                    of[0] = (f32x4){v[q][j][0], v[q][j][1], v[q][j][2], v[q][j][3]}; of[1] = (f32x4){v[q][j][4], v[q][j][5], v[q][j][6], v[q][j][7]}; }
                else {
                    ((GAS v4u*)(XR + (size_t)tok * D))[lane + 64 * j] = pack8(v[q][j]);
                    v2u w8; w8.x = pk4_fp8(v[q][j][0], v[q][j][1], v[q][j][2], v[q][j][3]); w8.y = pk4_fp8(v[q][j][4], v[q][j][5], v[q][j][6], v[q][j][7]);
                    ((GAS v2u*)(XB + (size_t)tok * D))[lane + 64 * j] = w8; }
            } } }
    }
}

__device__ __forceinline__ float dot64(const float (&q)[64], const bf16* krow) {
    float s = 0.f;
#pragma unroll
    for (int c = 0; c < 8; ++c) { const v4u kv = *(const v4u*)(krow + 8 * c);
        s += q[8 * c + 0] * __builtin_bit_cast(float, kv.x << 16) + q[8 * c + 1] * __builtin_bit_cast(float, kv.x & 0xffff0000u)
           + q[8 * c + 2] * __builtin_bit_cast(float, kv.y << 16) + q[8 * c + 3] * __builtin_bit_cast(float, kv.y & 0xffff0000u)
           + q[8 * c + 4] * __builtin_bit_cast(float, kv.z << 16) + q[8 * c + 5] * __builtin_bit_cast(float, kv.z & 0xffff0000u)
           + q[8 * c + 6] * __builtin_bit_cast(float, kv.w << 16) + q[8 * c + 7] * __builtin_bit_cast(float, kv.w & 0xffff0000u); }
    return s;
}
__device__ __forceinline__ void load_q64(float (&q)[64], const bf16* qrow) {
#pragma unroll
    for (int c = 0; c < 8; ++c) { const v4u kv = *(const v4u*)(qrow + 8 * c);
        q[8 * c + 0] = __builtin_bit_cast(float, kv.x << 16); q[8 * c + 1] = __builtin_bit_cast(float, kv.x & 0xffff0000u);
        q[8 * c + 2] = __builtin_bit_cast(float, kv.y << 16); q[8 * c + 3] = __builtin_bit_cast(float, kv.y & 0xffff0000u);
        q[8 * c + 4] = __builtin_bit_cast(float, kv.z << 16); q[8 * c + 5] = __builtin_bit_cast(float, kv.z & 0xffff0000u);
        q[8 * c + 6] = __builtin_bit_cast(float, kv.w << 16); q[8 * c + 7] = __builtin_bit_cast(float, kv.w & 0xffff0000u); }
}
__device__ __forceinline__ void swa_simple_phase(Frame& F, const bf16* QKV, const float* BT, const float* sinks, bf16* O) {
    const int lane = F.lane;
    for (int item = F.gw; item < T * NH; item += F.NGW) {
        const int tok = item >> 4, hq = item & 15, t = tok & (SEQ - 1), kvh = hq >> 3;
        float q[64]; load_q64(q, QKV + (size_t)tok * QKVA + hq * HD);
        const bf16* kbase = QKV + 1024 + kvh * HD; const bf16* vbase = QKV + 1152 + kvh * HD;
        const bool v0 = (t - lane) >= 0, v1 = (t - 64 - lane) >= 0;
        float s0 = -INFINITY, s1 = -INFINITY;
        if (v0) s0 = dot64(q, kbase + (size_t)(tok - lane) * QKVA) + BT[hq * 128 + lane];
        if (v1) s1 = dot64(q, kbase + (size_t)(tok - 64 - lane) * QKVA) + BT[hq * 128 + 64 + lane];
        const float sk = sinks[hq] * LOG2E;
        const float m = fmaxf(wave_max(fmaxf(s0, s1), lane), sk);
        float p0 = v0 ? exp2f(s0 - m) : 0.f, p1 = v1 ? exp2f(s1 - m) : 0.f;
        const float den = wave_sum(p0 + p1, lane) + exp2f(sk - m);
        p0 /= den; p1 /= den;
        float o = 0.f;
        for (int j = 0; j < 64; ++j) { const float pj = shfl_f(p0, j); if (t - j >= 0) o += pj * bf2f(vbase[(size_t)(tok - j) * QKVA + lane]); }
        for (int j = 0; j < 64; ++j) { const float pj = shfl_f(p1, j); if (t - 64 - j >= 0) o += pj * bf2f(vbase[(size_t)(tok - 64 - j) * QKVA + lane]); }
        O[(size_t)tok * D + hq * HD + lane] = (bf16)f2bf(o);
    }
}
__device__ __forceinline__ void sb_simple_phase(Frame& F, const bf16* QKV, bf16* O) {
    const int lane = F.lane;
    for (int item = F.gw; item < T * NH; item += F.NGW) {
        const int tok = item >> 4, hh = item & 15, t = tok & (SEQ - 1);
        float q[64]; load_q64(q, QKV + (size_t)tok * QKVB + hh * HD);
        const bf16* kbase = QKV + 1024 + hh * HD; const bf16* vbase = QKV + 2048 + hh * HD;
        float carry = 0.f, o = 0.f;
        for (int c0 = t - 1; c0 >= 0; c0 -= 64) {
            const int key = c0 - lane; const bool valid = key >= 0;
            float z2 = 0.f; if (valid) z2 = dot64(q, kbase + (size_t)(tok - t + key) * QKVB);
            const float sp = fmaxf(z2, 0.f) + log2f(1.0f + exp2f(-fabsf(z2)));
            const float L = valid ? -sp : 0.f;
            float incl = L;
#pragma unroll
            for (int ofs = 1; ofs < 64; ofs <<= 1) { const float tmp = shfl_f(incl, (lane - ofs) & 63); if (lane >= ofs) incl += tmp; }
            const float w = valid ? exp2f((z2 - sp) + carry + (incl - L)) : 0.f;
            carry += shfl_f(incl, 63);
            for (int j = 0; j < 64; ++j) { const float wj = shfl_f(w, j); if (c0 - j >= 0) o += wj * bf2f(vbase[(size_t)(tok - t + c0 - j) * QKVB + lane]); }
            if (carry < SB_EXIT) break;
        }
        O[(size_t)tok * D + hh * HD + lane] = (bf16)f2bf(o);
    }
}


typedef short v4i16_t __attribute__((ext_vector_type(4)));

__device__ __forceinline__ float other_half(float x, int hi) {
    auto rr = __builtin_amdgcn_permlane32_swap(__builtin_bit_cast(unsigned, x), __builtin_bit_cast(unsigned, x), false, false);
    return __builtin_bit_cast(float, hi ? rr[0] : rr[1]);
}
__device__ __forceinline__ bf16x8 vfrag(const LAS unsigned char* p) {
    const v4i16_t lo = __builtin_amdgcn_ds_read_tr16_b64_v4i16((LAS v4i16_t*)p), hi = __builtin_amdgcn_ds_read_tr16_b64_v4i16((LAS v4i16_t*)(p + 512));
    return (bf16x8){lo[0], lo[1], lo[2], lo[3], hi[0], hi[1], hi[2], hi[3]};
}
__device__ __forceinline__ bf16x8 pfrag(const f32x16& p, int s8) {
    v4u w; w.x = cvtpk(p[s8 + 0], p[s8 + 1]); w.y = cvtpk(p[s8 + 2], p[s8 + 3]); w.z = cvtpk(p[s8 + 4], p[s8 + 5]); w.w = cvtpk(p[s8 + 6], p[s8 + 7]);
    return __builtin_bit_cast(bf16x8, w);
}
__device__ __forceinline__ void load_k_tile(bf16x8 (&kr)[2][4], const bf16* Kh, size_t pitch, int kv0, int lane) {
    const bf16* kp = Kh + (size_t)(kv0 + (lane >> 3)) * pitch + 8 * (lane & 7);
#pragma unroll
    for (int i = 0; i < 8; ++i) kr[i >> 2][i & 3] = *(const GAS bf16x8*)(kp + (size_t)(8 * i) * pitch);
}
__device__ __forceinline__ void k_frags_via_lds(bf16x8 (&kf)[2][4], const bf16x8 (&kr)[2][4], LAS unsigned char* img, int lane) {
    const int rw = lane >> 3, cw = lane & 7;
#pragma unroll
    for (int i = 0; i < 8; ++i) *(LAS bf16x8*)(img + (8 * i + rw) * 128 + ((cw ^ rw) * 16)) = kr[i >> 2][i & 3];
    const int rr = lane & 31, hi = lane >> 5;
#pragma unroll
    for (int hf = 0; hf < 2; ++hf)
#pragma unroll
        for (int d0 = 0; d0 < 4; ++d0) kf[hf][d0] = *(const LAS bf16x8*)(img + (32 * hf + rr) * 128 + (((2 * d0 + hi) ^ (rr & 7)) * 16));
}
__device__ __forceinline__ void load_v_tile(v4u (&vr)[8], const bf16* Vh, size_t pitch, int kv0, int lane) {
    const bf16* vp = Vh + (size_t)(kv0 + (lane >> 3)) * pitch + 8 * (lane & 7);
#pragma unroll
    for (int i = 0; i < 8; ++i) vr[i] = *(const GAS v4u*)(vp + (size_t)(8 * i) * pitch);
}
__device__ __forceinline__ void store_v_tile(const v4u (&vr)[8], LAS unsigned char* vimg, int lane) {
    const int rw = lane >> 3, c = lane & 7;
#pragma unroll
    for (int i = 0; i < 8; ++i) *(LAS v4u*)(vimg + (c >> 2) * 4096 + (8 * i + rw) * 64 + (c & 3) * 16) = vr[i];
}
__device__ __forceinline__ void qk_tile(f32x16& p0, f32x16& p1, const bf16x8 (&kf)[2][4], const bf16x8 (&qf)[4]) {
    p0 = (f32x16){}; p1 = (f32x16){};
#pragma unroll
    for (int d0 = 0; d0 < 4; ++d0) { p0 = __builtin_amdgcn_mfma_f32_32x32x16_bf16(kf[0][d0], qf[d0], p0, 0, 0, 0); p1 = __builtin_amdgcn_mfma_f32_32x32x16_bf16(kf[1][d0], qf[d0], p1, 0, 0, 0); }
}
__device__ __forceinline__ void qk_half(f32x16& p, const bf16x8 (&kfh)[4], const bf16x8 (&qf)[4]) {
    p = (f32x16){};
#pragma unroll
    for (int d0 = 0; d0 < 4; ++d0) p = __builtin_amdgcn_mfma_f32_32x32x16_bf16(kfh[d0], qf[d0], p, 0, 0, 0);
}
template <int HF> __device__ __forceinline__ void pv_half(f32x16 (&o)[2], const f32x16& p, const LAS unsigned char* vtr) {
#pragma unroll
    for (int d0 = 0; d0 < 2; ++d0) {
        o[d0] = __builtin_amdgcn_mfma_f32_32x32x16_bf16(vfrag(vtr + d0 * 4096 + (2 * HF + 0) * 1024), pfrag(p, 0), o[d0], 0, 0, 0);
        o[d0] = __builtin_amdgcn_mfma_f32_32x32x16_bf16(vfrag(vtr + d0 * 4096 + (2 * HF + 1) * 1024), pfrag(p, 8), o[d0], 0, 0, 0);
    }
}
__device__ __forceinline__ void pv_tile(f32x16 (&o)[2], const f32x16& p0, const f32x16& p1, const LAS unsigned char* vtr) {
#pragma unroll
    for (int d0 = 0; d0 < 2; ++d0) {
        o[d0] = __builtin_amdgcn_mfma_f32_32x32x16_bf16(vfrag(vtr + d0 * 4096 + 0 * 1024), pfrag(p0, 0), o[d0], 0, 0, 0);
        o[d0] = __builtin_amdgcn_mfma_f32_32x32x16_bf16(vfrag(vtr + d0 * 4096 + 1 * 1024), pfrag(p0, 8), o[d0], 0, 0, 0);
        o[d0] = __builtin_amdgcn_mfma_f32_32x32x16_bf16(vfrag(vtr + d0 * 4096 + 2 * 1024), pfrag(p1, 0), o[d0], 0, 0, 0);
        o[d0] = __builtin_amdgcn_mfma_f32_32x32x16_bf16(vfrag(vtr + d0 * 4096 + 3 * 1024), pfrag(p1, 8), o[d0], 0, 0, 0);
    }
}
constexpr float O_SCALE = 16.0f;
__device__ __forceinline__ void store_o(const f32x16 (&o)[2], float sc, unsigned char* Orow  , int hi) {
    sc *= O_SCALE;
#pragma unroll
    for (int d0 = 0; d0 < 2; ++d0)
#pragma unroll
        for (int g = 0; g < 4; ++g) *(unsigned*)(Orow + 32 * d0 + 8 * g + 4 * hi) = pk4_fp8(o[d0][4 * g] * sc, o[d0][4 * g + 1] * sc, o[d0][4 * g + 2] * sc, o[d0][4 * g + 3] * sc);
}
__device__ __forceinline__ void load_q_frag(bf16x8 (&q)[4], const bf16* qp) {
#pragma unroll
    for (int d0 = 0; d0 < 4; ++d0) q[d0] = *(const GAS bf16x8*)(qp + 16 * d0);
}
__device__ __forceinline__ void swa_phase(Frame& F, const bf16* QKV, const float* BT, const float* sinks, unsigned char* O) {
    const int lane = F.lane, ql = lane & 31, hi = lane >> 5;
    LAS unsigned char* vimg = F.lds + F.wave * 16384;
    LAS float* tb = (LAS float*)(vimg + 8192);
    const LAS unsigned char* vtr = vimg + ((lane >> 4) & 1) * 32 + (lane & 3) * 8 + (4 * hi + ((lane & 15) >> 2)) * 64;
    constexpr int NITEMS = (T / 32) * NH;
    int item = F.gw; if (item >= NITEMS) return;
    int hq_tb = -1;
    bf16x8 qf[4]; bf16x8 kfn[2][4]; v4u vrn[8];
    { const int blk = item >> 4, hq = item & 15, kvh = hq >> 3, bb = blk >> 8, r0 = (blk & 255) * 32; const size_t tok0 = (size_t)bb * SEQ;
      const bf16* Kh = QKV + tok0 * QKVA + 1024 + kvh * HD; const int tmax = (r0 + 31) >> 6;
      load_q_frag(qf, QKV + (tok0 + r0 + ql) * QKVA + hq * HD + 8 * hi); load_k_tile(kfn, Kh, QKVA, tmax * 64, lane); load_v_tile(vrn, Kh + 128, QKVA, tmax * 64, lane); }
    for (;;) {
        const int blk = item >> 4, hq = item & 15, kvh = hq >> 3, bb = blk >> 8, r0 = (blk & 255) * 32;
        const size_t tok0 = (size_t)bb * SEQ;
        if (hq != hq_tb) { for (int i = lane; i < 320; i += 64) { const int dist = i - 96; tb[i] = (dist >= 0 && dist < 128) ? BT[hq * 128 + dist] : -INFINITY; } hq_tb = hq; }
        const bf16* Kh = QKV + tok0 * QKVA + 1024 + kvh * HD; const bf16* Vh = Kh + 128;
        const float sk = sinks[hq] * LOG2E;
        float m = sk, l = 0.f; f32x16 o[2]; o[0] = (f32x16){}; o[1] = (f32x16){};
        const int tmax = (r0 + 31) >> 6; int tmin = (r0 - 127) >> 6; if (tmin < 0) tmin = 0;
        const int item2 = item + F.NGW; const bool has2 = item2 < NITEMS;
        const int blkb = item2 >> 4, hqb = item2 & 15, bbb = blkb >> 8, r0b = (blkb & 255) * 32; const size_t tok0b = (size_t)bbb * SEQ;
        const bf16* Khb = QKV + tok0b * QKVA + 1024 + (hqb >> 3) * HD; const int tmaxb = (r0b + 31) >> 6;
        for (int t = tmax; t >= tmin; --t) {
            const int kv0 = t * 64;
            bf16x8 kf[2][4];
            k_frags_via_lds(kf, kfn, vimg, lane);
            store_v_tile(vrn, vimg, lane);
            if (t > tmin) { load_k_tile(kfn, Kh, QKVA, kv0 - 64, lane); load_v_tile(vrn, Vh, QKVA, kv0 - 64, lane); }
            else if (has2) { load_k_tile(kfn, Khb, QKVA, tmaxb * 64, lane); load_v_tile(vrn, Khb + 128, QKVA, tmaxb * 64, lane); }
            const bool sk0 = kv0 + 31 < r0 - 127, sk1 = kv0 + 32 > r0 + 31;
            f32x16 p0 = {}, p1 = {};
            if (!sk0) qk_half(p0, kf[0], qf);
            if (!sk1) qk_half(p1, kf[1], qf);
            if (t == tmin && has2) load_q_frag(qf, QKV + (tok0b + r0b + ql) * QKVA + hqb * HD + 8 * hi);
            const LAS float* tp = tb + (96 + r0 + ql - kv0 - 4 * hi - 59);
            float mx = -INFINITY;
            if (!sk0) {
#pragma unroll
                for (int r = 0; r < 16; ++r) { p0[r] += tp[59 - ((r & 3) + 8 * (r >> 2))]; mx = fmaxf(mx, p0[r]); } }
            if (!sk1) {
#pragma unroll
                for (int r = 0; r < 16; ++r) { p1[r] += tp[27 - ((r & 3) + 8 * (r >> 2))]; mx = fmaxf(mx, p1[r]); } }
            mx = fmaxf(mx, other_half(mx, hi));
            const float mn = fmaxf(m, mx), alpha = __builtin_amdgcn_exp2f(m - mn); m = mn;
            float ls = 0.f;
            if (!sk0) {
#pragma unroll
                for (int r = 0; r < 16; ++r) { p0[r] = __builtin_amdgcn_exp2f(p0[r] - mn); ls += p0[r]; } }
            if (!sk1) {
#pragma unroll
                for (int r = 0; r < 16; ++r) { p1[r] = __builtin_amdgcn_exp2f(p1[r] - mn); ls += p1[r]; } }
            l = l * alpha + ls;
#pragma unroll
            for (int r = 0; r < 16; ++r) { o[0][r] *= alpha; o[1][r] *= alpha; }
            if (!sk0) pv_half<0>(o, p0, vtr);
            if (!sk1) pv_half<1>(o, p1, vtr);
        }
        const float den = l + other_half(l, hi) + __builtin_amdgcn_exp2f(sk - m);
        store_o(o, 1.0f / den, O + (tok0 + r0 + ql) * D + hq * HD, hi);
        if (!has2) break;
        item = item2;
    }
}
__device__ __forceinline__ void sb_phase(Frame& F, const bf16* QKV, unsigned char* O) {
    const int lane = F.lane, ql = lane & 31, hi = lane >> 5;
    LAS unsigned char* vimg = F.lds + F.wave * 16384;
    const LAS unsigned char* vtr = vimg + ((lane >> 4) & 1) * 32 + (lane & 3) * 8 + (4 * hi + ((lane & 15) >> 2)) * 64;
    constexpr int NITEMS = (T / 32) * NH;
    int item = F.gw; if (item >= NITEMS) return;
    bf16x8 qf[4]; bf16x8 kfn[2][4]; v4u vrn[8];
    { const int hh = item >> 10, blk = item & 1023, bb = blk >> 8, r0 = (blk & 255) * 32; const size_t tok0 = (size_t)bb * SEQ;
      const bf16* Kh = QKV + tok0 * QKVB + 1024 + hh * HD; const int tmax = (r0 + 31) >> 6;
      load_q_frag(qf, QKV + (tok0 + r0 + ql) * QKVB + hh * HD + 8 * hi); load_k_tile(kfn, Kh, QKVB, tmax * 64, lane); load_v_tile(vrn, Kh + 1024, QKVB, tmax * 64, lane); }
    for (;;) {
        const int hh = item >> 10, blk = item & 1023, bb = blk >> 8, r0 = (blk & 255) * 32;
        const size_t tok0 = (size_t)bb * SEQ;
        const bf16* Kh = QKV + tok0 * QKVB + 1024 + hh * HD; const bf16* Vh = Kh + 1024;
        float cpos = 0.f; f32x16 o[2]; o[0] = (f32x16){}; o[1] = (f32x16){};
        const int tmax = (r0 + 31) >> 6, qabs = r0 + ql;
        const int item2 = item + F.NGW; const bool has2 = item2 < NITEMS;
#define SB_NEXT_DECODE() int i2_ = item2; asm volatile("" : "+s"(i2_));   \
        const int hhb = i2_ >> 10, blkb = i2_ & 1023, bbb = blkb >> 8, r0b = (blkb & 255) * 32; const size_t tok0b = (size_t)bbb * SEQ; \
        const bf16* Khb = QKV + tok0b * QKVB + 1024 + hhb * HD; const int tmaxb = (r0b + 31) >> 6; (void)tmaxb; (void)Khb;
        bool have = true;
        bool nextq = false;
        for (int t = tmax; t >= 0; --t) {
            const int kv0 = t * 64;
            bf16x8 kf[2][4];
            if (!have) { load_k_tile(kfn, Kh, QKVB, kv0, lane); load_v_tile(vrn, Vh, QKVB, kv0, lane); nextq = false; }
            k_frags_via_lds(kf, kfn, vimg, lane);
            store_v_tile(vrn, vimg, lane);
            bool have_next = false;
            if (t == tmax && t > 0) { load_k_tile(kfn, Kh, QKVB, kv0 - 64, lane); load_v_tile(vrn, Vh, QKVB, kv0 - 64, lane); have_next = true; }
            else if (!nextq && has2) { SB_NEXT_DECODE(); load_k_tile(kfn, Khb, QKVB, tmaxb * 64, lane); load_v_tile(vrn, Khb + 1024, QKVB, tmaxb * 64, lane); nextq = true; }
            f32x16 p0, p1; qk_tile(p0, p1, kf, qf);
            f32x16 s0, s1;
            const bool diag = (t == tmax);
#pragma unroll
            for (int r = 0; r < 16; ++r) {
                { const float z = p0[r], sp = fmaxf(z, 0.f) + __builtin_amdgcn_logf(1.0f + __builtin_amdgcn_exp2f(-fabsf(z))); s0[r] = sp; p0[r] = z - sp; }
                { const float z = p1[r], sp = fmaxf(z, 0.f) + __builtin_amdgcn_logf(1.0f + __builtin_amdgcn_exp2f(-fabsf(z))); s1[r] = sp; p1[r] = z - sp; }
            }
            if (diag) {
#pragma unroll
                for (int r = 0; r < 16; ++r) { const int kv = kv0 + crow(r, hi);
                    if (kv >= qabs) { s0[r] = 0.f; p0[r] = -INFINITY; }
                    if (kv + 32 >= qabs) { s1[r] = 0.f; p1[r] = -INFINITY; } }
            }
            float T8[9];
#pragma unroll
            for (int mI = 0; mI < 8; ++mI) { const f32x16& sv = mI < 4 ? s0 : s1; const int b = 4 * (mI & 3); T8[mI] = (sv[b + 3] + sv[b + 2]) + (sv[b + 1] + sv[b]); }
            T8[8] = 0.f;
#pragma unroll
            for (int mI = 6; mI >= 0; --mI) T8[mI] += T8[mI + 1];
            float U8[9];
#pragma unroll
            for (int mI = 0; mI < 8; ++mI) U8[mI] = other_half(T8[mI], hi);
            U8[8] = 0.f;
#pragma unroll
            for (int mI = 0; mI < 8; ++mI) { const float X = cpos + T8[mI + 1] + (hi ? U8[mI + 1] : U8[mI]); f32x16& pv = mI < 4 ? p0 : p1; const f32x16& sv = mI < 4 ? s0 : s1; const int b = 4 * (mI & 3);
                const float e2 = X + sv[b + 3], e1 = e2 + sv[b + 2], e0 = e1 + sv[b + 1];
                pv[b + 3] = __builtin_amdgcn_exp2f(pv[b + 3] - X); pv[b + 2] = __builtin_amdgcn_exp2f(pv[b + 2] - e2);
                pv[b + 1] = __builtin_amdgcn_exp2f(pv[b + 1] - e1); pv[b] = __builtin_amdgcn_exp2f(pv[b] - e0); }
            cpos += T8[0] + U8[0];
            pv_tile(o, p0, p1, vtr);
            if (__all(cpos > -SB_EXIT)) break;
            have = have_next;
        }
        store_o(o, 1.0f, O + (tok0 + r0 + ql) * D + hh * HD, hi);
        if (!has2) break;
        { SB_NEXT_DECODE();
          load_q_frag(qf, QKV + (tok0b + r0b + ql) * QKVB + hhb * HD + 8 * hi);
          if (!nextq) { load_k_tile(kfn, Khb, QKVB, tmaxb * 64, lane); load_v_tile(vrn, Khb + 1024, QKVB, tmaxb * 64, lane); } }
#undef SB_NEXT_DECODE
        item = item2;
    }
}

struct EpiQkv { bf16* O; int ldc; const float* bias; __device__ __forceinline__ void operator()(int r, int c, float v) const {
    if (bias) v += bias[c]; if (c < 1024) v *= QSCALE; O[(size_t)r * ldc + c] = (bf16)f2bf(v); } };
struct EpiOut { float* Z; const float* xres; const float* bias; __device__ __forceinline__ void operator()(int r, int c, float v) const {
    if (bias) v += bias[c]; Z[(size_t)r * D + c] = v + DN_ALPHA * xres[(size_t)r * D + c]; } };

__device__ __forceinline__ void moe_gateup_simple(Frame& F, const bf16* XG, const bf16* WGU  , const float* bgu  , const unsigned* NMT, const unsigned* TILEE, bf16* ACT) {
    const int nmt = (int)NMT[0], j = F.lane & 31, h = F.lane >> 5;
    const int total = nmt * 8 * 32;
    for (int it = F.gw; it < total; it += F.NGW) {
        const int rt = it >> 5, jg = it & 31, row0 = rt * 32, e = (int)TILEE[row0 >> 8], j0 = jg * 32;
        const bf16* W = WGU + (size_t)e * 2048 * D;
        const int ng = 256 * (j0 >> 7) + (j0 & 127), nu = ng + 128;
        f32x16 ag = {}, au = {};
        wave_gemm2(XG + (size_t)(row0 + j) * D + 8 * h, W + (size_t)(ng + j) * D + 8 * h, W + (size_t)(nu + j) * D + 8 * h, D, ag, au);
        const float bg = bgu[e * 2048 + j0 + j], bu = bgu[e * 2048 + 1024 + j0 + j];
#pragma unroll
        for (int r = 0; r < 16; ++r) {
            float gg = fminf(ag[r] + bg, 7.0f), uu = fminf(fmaxf(au[r] + bu, -7.0f), 7.0f);
            const float act = (uu + 1.0f) * (gg / (1.0f + __expf(-1.702f * gg)));
            ACT[(size_t)(row0 + crow(r, h)) * DFF + j0 + j] = (bf16)f2bf(act);
        }
    }
}
__device__ __forceinline__ void moe_down_simple(Frame& F, const bf16* ACT, const bf16* WD, const float* bd  , const float* SGATE, const unsigned* NMT, const unsigned* TILEE, bf16* Y) {
    const int nmt = (int)NMT[0], j = F.lane & 31, h = F.lane >> 5;
    const int total = nmt * 8 * 16;
    for (int it = F.gw; it < total; it += F.NGW) {
        const int rt = it >> 4, cg = it & 15, row0 = rt * 32, e = (int)TILEE[row0 >> 8], c0 = cg * 64;
        const bf16* W = WD + (size_t)e * D * DFF;
        f32x16 a0 = {}, a1 = {};
        wave_gemm2(ACT + (size_t)(row0 + j) * DFF + 8 * h, W + (size_t)(c0 + j) * DFF + 8 * h, W + (size_t)(c0 + 32 + j) * DFF + 8 * h, DFF, a0, a1);
        const float b0 = bd[e * D + c0 + j], b1 = bd[e * D + c0 + 32 + j];
#pragma unroll
        for (int r = 0; r < 16; ++r) { const int row = row0 + crow(r, h); const float gt = SGATE[row];
            Y[(size_t)row * D + c0 + j] = (bf16)f2bf((a0[r] + b0) * gt); Y[(size_t)row * D + c0 + 32 + j] = (bf16)f2bf((a1[r] + b1) * gt); }
    }
}

constexpr int PH_PER_LAYER = 8, N_PHASES = 1 + DEPTH * PH_PER_LAYER;
template <class Tp> __device__ __forceinline__ Tp* launder(Tp* p) { asm volatile("" : "+s"(p)); return p; }
__global__ void __launch_bounds__(NTHREADS, 2) fwd(Args args) {
    extern __shared__ __attribute__((aligned(16))) unsigned char lds[];
    Frame F; F.lds = (LAS unsigned char*)lds; F.tid = threadIdx.x; F.lane = F.tid & 63; F.wave = __builtin_amdgcn_readfirstlane(F.tid >> 6);
    F.gw = blockIdx.x * NWAVES + F.wave; F.NGW = gridDim.x * NWAVES;
#define FRAME() do { int t_ = threadIdx.x; asm volatile("" : "+v"(t_)); F.tid = t_; F.lane = t_ & 63; F.wave = __builtin_amdgcn_readfirstlane(t_ >> 6); F.gw = blockIdx.x * NWAVES + F.wave; } while (0)
    const int lo = args.ph_lo, hi = args.ph_hi;
    for (int u = F.tid; u < 64; u += NTHREADS) ((LAS unsigned*)(F.lds + LDSCTL_OFF))[u] = 0u;
    __syncthreads();
    XcdBarrier bar; bar.bar = (unsigned*)(args.ws + WS_CTL) + CW_BAR; bar.x = 0; bar.st = nullptr;
    if (hi - lo > 1) bar = xcd_barrier_post((unsigned*)(args.ws + WS_CTL) + CW_BAR, (volatile LAS unsigned*)(F.lds + LDSCTL_OFF + 64));
#define IN(k) (lo <= (k) && (k) < hi)
#define SEAM(k) do { if (IN(k) && IN((k) + 1)) for (int rep = 0; rep <= ((PROBE_REPEAT >> 8) & 1); ++rep) { XcdBarrier b2 = bar; b2.bar = launder(bar.bar); asm volatile("" : "+s"(b2.x)); xcd_barrier(b2); } } while (0)
#define WSP(T_, off) ((T_*)(launder(args.ws) + (off)))
    if (IN(0)) for (int rep = 0; rep <= ((PROBE_REPEAT >> 0) & 1); ++rep) { FRAME(); prologue_phase(F, args); }
    SEAM(0);
    for (int i = 0; i < DEPTH; ++i) {
        const int base = 1 + i * PH_PER_LAYER, jl = i >> 1; const bool isA = (i & 1) == 0;
        if (IN(base + 0)) for (int rep = 0; rep <= ((PROBE_REPEAT >> 1) & 1); ++rep) {
            unsigned char* ws = launder(args.ws);
            const int Nq = isA ? QKVA : QKVB;
            const unsigned char* Wt = isA ? ws + WS_WQKVA + (size_t)jl * QKVA * D : ws + WS_WQKVB + (size_t)jl * QKVB * D;
            pg8::Gemm g{(const bf16*)(ws + WS_XB), (const bf16*)Wt, T, Nq, D / 2, 0, nullptr, LT_SB}; pg8::StaticOrder S; S.init(T, Nq, (int)gridDim.x, (int)blockIdx.x);
            pg8::EpiBf16<0> E{(bf16*)(ws + WS_QKV), Nq, isA ? launder(args.in[3]) + (size_t)jl * QKVA : nullptr, 1024, 1024, QSCALE, 1.0f / WGU_SCALE};
            pg8::gemm_phase<pg8::EpiBf16<0>, pg8::StaticOrder, true, true, true, true>(F.lds, g, S, E);
        }
        SEAM(base + 0);
        if (IN(base + 1)) for (int rep = 0; rep <= ((PROBE_REPEAT >> 2) & 1); ++rep) {
            FRAME(); unsigned char* ws = launder(args.ws);
            const int ncv = (CONV_CUS > 0 && (int)gridDim.x >= CONV_CUS + 64) ? (isA ? CONV_CUS_A : CONV_CUS) : 0;
            if ((int)blockIdx.x < ncv) {
                convert_stream<2, false>(F.gw, ncv * NWAVES, F.lane, launder(args.in[17]) + (size_t)i * NEXP * DFF * D, ws + WS_WD + (size_t)i * NEXP * D * DFF, NEXP, DFF, D, (LAS float*)(F.lds + F.wave * CONV_SLOT));
                if (CONV_GU > 0) convert_stream<1, true>(F.gw, ncv * NWAVES, F.lane, launder(args.in[15]) + (size_t)i * NEXP * D * 2 * DFF, ws + WS_WGU + (size_t)i * NEXP * D * 2 * DFF, CONV_GU, D, 2 * DFF, (LAS float*)(F.lds + F.wave * CONV_SLOT));
            } else {
                F.gw -= ncv * NWAVES; F.NGW = ((int)gridDim.x - ncv) * NWAVES;
                if (isA) swa_phase(F, (const bf16*)(ws + WS_QKV), (const float*)(ws + WS_BT), launder(args.in[4]) + jl * NH, ws + WS_O);
                else     sb_phase(F, (const bf16*)(ws + WS_QKV), ws + WS_O);
                F.NGW = (int)gridDim.x * NWAVES;
            }
        }
        SEAM(base + 1);
        if (IN(base + 2)) for (int rep = 0; rep <= ((PROBE_REPEAT >> 3) & 1); ++rep) {
            unsigned char* ws = launder(args.ws);
            const unsigned char* Wt = isA ? ws + WS_WOA + (size_t)jl * D * D : ws + WS_WOB + (size_t)jl * D * D;
            pg8::Gemm g{(const bf16*)(ws + WS_O), (const bf16*)Wt, T, D, D / 2, 0, nullptr, LT_SB}; pg8::StaticOrder S; S.init(T, D, (int)gridDim.x, (int)blockIdx.x);
            pg8::EpiZ16 E{(bf16*)(ws + WS_Z), (const bf16*)(ws + WS_XF), isA ? launder(args.in[6]) + (size_t)jl * D : nullptr, D, DN_ALPHA, 1.0f / (WGU_SCALE * O_SCALE)};
            pg8::gemm_phase<pg8::EpiZ16, pg8::StaticOrder, true, true, true, true>(F.lds, g, S, E);
        }
        SEAM(base + 2);
        if (IN(base + 3)) for (int rep = 0; rep <= ((PROBE_REPEAT >> 9) & 1); ++rep) { FRAME(); unsigned char* ws = launder(args.ws);
            ln1_router_phase(F, (const bf16*)(ws + WS_Z), launder(args.in[9]) + (size_t)i * D, launder(args.in[10]) + (size_t)i * D, (const bf16*)(ws + WS_WRT) + (size_t)i * 2 * NEXP * D, launder(args.in[14]) + (size_t)i * NEXP,
                             (bf16*)(ws + WS_X1F), ws + WS_X18, (int*)(ws + WS_TOPE), (float*)(ws + WS_TOPG), (int*)(ws + WS_POS),
                             (unsigned*)(ws + WS_CTL) + CW_CNT + CNT_LAYER * i, (int*)(ws + WS_LIST), (float*)(ws + WS_LGATE), (int*)(ws + WS_LISTK), 1); }
        SEAM(base + 3);
        if (IN(base + 4)) { FRAME(); unsigned char* ws = launder(args.ws);
            ln1_router_phase(F, (const bf16*)(ws + WS_Z), launder(args.in[9]) + (size_t)i * D, launder(args.in[10]) + (size_t)i * D, (const bf16*)(ws + WS_WRT) + (size_t)i * 2 * NEXP * D, launder(args.in[14]) + (size_t)i * NEXP,
                             (bf16*)(ws + WS_X1F), ws + WS_X18, (int*)(ws + WS_TOPE), (float*)(ws + WS_TOPG), (int*)(ws + WS_POS),
                             (unsigned*)(ws + WS_CTL) + CW_CNT + CNT_LAYER * i, (int*)(ws + WS_LIST), (float*)(ws + WS_LGATE), (int*)(ws + WS_LISTK), 3); }
        SEAM(base + 4);
        if (IN(base + 5)) for (int rep = 0; rep <= ((PROBE_REPEAT >> 5) & 1); ++rep) {
            FRAME(); unsigned char* ws = launder(args.ws);
            moe_tables(F, (unsigned*)(ws + WS_CTL) + CW_CNT + CNT_LAYER * i);
            const int nmt = __builtin_amdgcn_readfirstlane(((const LAS int*)(F.lds + LT_NMT))[0]);
            pg8::Gemm g{(const bf16*)(ws + WS_X18), (const bf16*)(ws + WS_WGU + (size_t)i * NEXP * 2048 * D), nmt * 256, 2048, D / 2, (size_t)2048 * D, (const int*)(ws + WS_LIST), LT_SB};
            pg8::MoeOrder S; S.init(nmt, 2048, (int)gridDim.x, (int)blockIdx.x, (const LAS int*)(F.lds + LT_E), (const LAS int*)(F.lds + LT_TE), (const LAS int*)(F.lds + LT_CNT));
            pg8::EpiSwiglu E{(bf16*)(ws + WS_ACT), launder(args.in[16]) + (size_t)i * NEXP * 2048, 1.0f / WGU_SCALE};
            pg8::gemm_phase<pg8::EpiSwiglu, pg8::MoeOrder, true, true, true, true>(F.lds, g, S, E);
        }
        SEAM(base + 5);
        if (IN(base + 6)) for (int rep = 0; rep <= ((PROBE_REPEAT >> 6) & 1); ++rep) {
            FRAME(); unsigned char* ws = launder(args.ws);
            if (!IN(base + 5)) moe_tables(F, (unsigned*)(ws + WS_CTL) + CW_CNT + CNT_LAYER * i);
            const int nmt = __builtin_amdgcn_readfirstlane(((const LAS int*)(F.lds + LT_NMT))[0]);
            pg8::Gemm g{(const bf16*)(ws + WS_ACT), (const bf16*)(ws + WS_WD + (size_t)i * NEXP * D * DFF), nmt * 256, D, DFF / 2, (size_t)D * DFF, nullptr, LT_SB};
            pg8::MoeOrder S; S.init(nmt, D, (int)gridDim.x, (int)blockIdx.x, (const LAS int*)(F.lds + LT_E), (const LAS int*)(F.lds + LT_TE), (const LAS int*)(F.lds + LT_CNT));
            pg8::EpiDown E{(const int*)(ws + WS_LISTK), (bf16*)(ws + WS_Y), launder(args.in[18]) + (size_t)i * NEXP * D, (const float*)(ws + WS_LGATE), 1.0f / (WD_SCALE * ACT_SCALE)};
            pg8::gemm_phase<pg8::EpiDown, pg8::MoeOrder, true, true, true, true>(F.lds, g, S, E);
        }
        SEAM(base + 6);
        if (IN(base + 7)) for (int rep = 0; rep <= ((PROBE_REPEAT >> 7) & 1); ++rep) { FRAME(); unsigned char* ws = launder(args.ws);
            ln2_phase(F, (const bf16*)(ws + WS_X1F), (const bf16*)(ws + WS_Y), (const int*)(ws + WS_TOPE), (const int*)(ws + WS_POS), launder(args.in[11]) + (size_t)i * D, launder(args.in[12]) + (size_t)i * D,
                      (bf16*)(ws + WS_XF), launder(args.out), ws + WS_XB, i == DEPTH - 1); }
        SEAM(base + 7);
    }
#undef IN
#undef SEAM
#undef WSP
#undef FRAME
}

#ifndef N_LAUNCHES
#define N_LAUNCHES 1
#endif
extern "C" void kernel_launch(void* const* d_in, const int* in_sizes, int n_in, void* d_out, int out_size, void* d_ws, size_t ws_size, hipStream_t stream) {
    static int grid = 0;
    if (grid == 0) {
        if (n_in != 19 || out_size != T * D || ws_size < WS_END) { fprintf(stderr, "kernel_launch: unexpected shapes (n_in %d out %d ws %zu)\n", n_in, out_size, ws_size); grid = -1; return; }
        int dev = 0, cus = 0, per_cu = 0;
        if (hipGetDevice(&dev) != hipSuccess || hipDeviceGetAttribute(&cus, hipDeviceAttributeMultiprocessorCount, dev) != hipSuccess) { grid = -1; return; }
        if (hipFuncSetAttribute((const void*)fwd, hipFuncAttributeMaxDynamicSharedMemorySize, LDS_BYTES) != hipSuccess) { grid = -1; return; }
        if (hipOccupancyMaxActiveBlocksPerMultiprocessor(&per_cu, (const void*)fwd, NTHREADS, LDS_BYTES) != hipSuccess || per_cu < 1) { fprintf(stderr, "kernel_launch: occupancy query says %d blocks per CU\n", per_cu); (void)hipGetLastError(); }
        grid = cus;
    }
    if (grid < 0) return;
    (void)hipMemsetAsync((char*)d_ws + WS_CTL, 0, CTL_ZERO_BYTES, stream);
    Args a{};
    for (int i = 0; i < 19; ++i) a.in[i] = (const float*)d_in[i];
    a.out = (float*)d_out; a.ws = (unsigned char*)d_ws;
    if (N_LAUNCHES == 1) { a.ph_lo = 0; a.ph_hi = N_PHASES; hipLaunchKernelGGL(fwd, dim3(grid), dim3(NTHREADS), LDS_BYTES, stream, a); }
    else for (int p = 0; p < N_PHASES; ++p) { a.ph_lo = p; a.ph_hi = p + 1; hipLaunchKernelGGL(fwd, dim3(grid), dim3(NTHREADS), LDS_BYTES, stream, a); }
}
```

```cpp
#include <hip/hip_runtime.h>
#include <cstdio>
#include <cstdint>
#ifndef FP8_EMU
#define FP8_EMU 0
#endif
#ifndef RES16_EMU
#define RES16_EMU 0
#endif
#ifndef PROBE_REPEAT
#define PROBE_REPEAT 0
#endif

#define GAS __attribute__((address_space(1)))
#define LAS __attribute__((address_space(3)))
typedef unsigned short bf16;
typedef unsigned v4u __attribute__((ext_vector_type(4)));
typedef unsigned v2u __attribute__((ext_vector_type(2)));
typedef float f32x4 __attribute__((ext_vector_type(4)));
typedef float f32x16 __attribute__((ext_vector_type(16)));
typedef short bf16x8 __attribute__((ext_vector_type(8)));

constexpr int BATCH = 4, SEQ = 8192, T = BATCH * SEQ, D = 1024, DEPTH = 4, NEXP = 32, TOPK = 4, HD = 64, NH = 16;
constexpr int QKVA = 1280, QKVB = 3072, DFF = 1024;
constexpr int NSLOT = (T * TOPK / 256 + NEXP) * 256;
constexpr int MAXMT = NSLOT / 256;
constexpr float LN_EPS = 1e-5f;
constexpr float DN_ALPHA = 1.681792830507429f;
constexpr float LOG2E = 1.4426950408889634f;
constexpr float QSCALE = 0.125f * LOG2E;
constexpr float SB_EXIT = -48.0f;

constexpr size_t MiB = 1u << 20;
constexpr size_t WS_CTL = 0, CTL_ZERO_BYTES = 1 * MiB;
constexpr size_t WS_BT = 1 * MiB;
constexpr size_t WS_WRT = 1 * MiB + 65536;
constexpr size_t WS_WQKVA = 2 * MiB, WS_WOA = 8 * MiB, WS_WQKVB = 12 * MiB, WS_WOB = 24 * MiB;
constexpr size_t WS_WGU = 32 * MiB, WS_WD = 544 * MiB;
constexpr size_t WS_XF = 800 * MiB, WS_XB = 928 * MiB, WS_QKV = 992 * MiB, WS_O = 1184 * MiB, WS_Z = 1248 * MiB;
constexpr size_t WS_X1F = 1376 * MiB, WS_X1B = 1504 * MiB, WS_X18 = 1568 * MiB, WS_ACT = 1840 * MiB, WS_Y = 2112 * MiB;
constexpr size_t WS_TOPE = 2384 * MiB, WS_TOPG = WS_TOPE + 512 * 1024, WS_POS = WS_TOPG + 512 * 1024;
constexpr size_t WS_LIST = 2386 * MiB, WS_LGATE = 2390 * MiB;
constexpr size_t WS_LISTK = 2394 * MiB;
constexpr size_t WS_END = 2398 * MiB;
constexpr int CW_CNT = 32768, CNT_STRIDE = 64, CNT_LAYER = NEXP * CNT_STRIDE;
constexpr int CW_NMT = 512;
constexpr int CW_TILEE = 1024;
constexpr int CW_PADS = 8192;
constexpr int CW_BAR = 16384;

constexpr int NWAVES = 8, NTHREADS = 512;
#ifndef CONV_GU
#define CONV_GU 32
#endif
#ifndef CONV_CUS_A
#define CONV_CUS_A 108
#endif
#ifndef CONV_CUS
#define CONV_CUS 98
#endif
constexpr int LDS_BYTES = 147456;
constexpr int LDSCTL_OFF = 133120;
constexpr int LT_E = LDSCTL_OFF + 256, LT_TE = LT_E + 4 * MAXMT, LT_PSTART = LT_TE + 4 * MAXMT, LT_CNT = LT_PSTART + 128, LT_NMT = LT_CNT + 128;
constexpr int LT_SB = LT_NMT + 16;
static_assert(LT_SB % 16 == 0 && LT_SB + 2 * 3072 + 1024 <= LDS_BYTES && 8 * 64 * 65 * 4 <= LDSCTL_OFF, "LDS control area");

struct Args { const float* in[19]; float* out; unsigned char* ws; int ph_lo, ph_hi; };

struct Frame {
    LAS unsigned char* lds;
    int tid, lane, wave, gw, NGW;
};

__device__ __forceinline__ unsigned f2bf(float f) { unsigned u = __builtin_bit_cast(unsigned, f); return (u + 0x7fffu + ((u >> 16) & 1u)) >> 16; }
__device__ __forceinline__ unsigned pk2(float lo, float hi) { return f2bf(lo) | (f2bf(hi) << 16); }
typedef float f32x2_t __attribute__((ext_vector_type(2))); typedef __bf16 bf16x2_t __attribute__((ext_vector_type(2)));
__device__ __forceinline__ unsigned cvtpk(float lo, float hi) { const f32x2_t v = {lo, hi}; const bf16x2_t b = __builtin_convertvector(v, bf16x2_t); return __builtin_bit_cast(unsigned, b); }
__device__ __forceinline__ void unpack8(const v4u w, float (&f)[8]) {
    f[0] = __builtin_bit_cast(float, w.x << 16); f[1] = __builtin_bit_cast(float, w.x & 0xffff0000u); f[2] = __builtin_bit_cast(float, w.y << 16); f[3] = __builtin_bit_cast(float, w.y & 0xffff0000u);
    f[4] = __builtin_bit_cast(float, w.z << 16); f[5] = __builtin_bit_cast(float, w.z & 0xffff0000u); f[6] = __builtin_bit_cast(float, w.w << 16); f[7] = __builtin_bit_cast(float, w.w & 0xffff0000u);
}
__device__ __forceinline__ v4u pack8(const float (&f)[8]) { v4u w; w.x = cvtpk(f[0], f[1]); w.y = cvtpk(f[2], f[3]); w.z = cvtpk(f[4], f[5]); w.w = cvtpk(f[6], f[7]); return w; }
__device__ __forceinline__ float bf16r(float x) { return RES16_EMU ? __builtin_bit_cast(float, f2bf(x) << 16) : x; }
__device__ __forceinline__ f32x4 bf16r4(f32x4 v) { f32x4 r; r.x = bf16r(v.x); r.y = bf16r(v.y); r.z = bf16r(v.z); r.w = bf16r(v.w); return r; }
__device__ __forceinline__ unsigned pk4_fp8(float a, float b, float c, float d) {
    int r = __builtin_amdgcn_cvt_pk_fp8_f32(a, b, 0, false); r = __builtin_amdgcn_cvt_pk_fp8_f32(c, d, r, true); return (unsigned)r;
}
constexpr float Y_SCALE = 16.0f;
constexpr float WD_SCALE = 64.0f, ACT_SCALE = 4.0f;
constexpr float WGU_SCALE = 32.0f;
__device__ __forceinline__ float e4m3r(float x) {
    const float ax = fabsf(x);
    if (ax < 0.015625f) return copysignf(rintf(ax * 512.0f) * (1.0f / 512.0f), x);
    unsigned u = __builtin_bit_cast(unsigned, x); u += 0x7FFFFu + ((u >> 20) & 1u); u &= 0xFFF00000u;
    const float r = __builtin_bit_cast(float, u); return fminf(fmaxf(r, -448.0f), 448.0f);
}
__device__ __forceinline__ float bf2f(unsigned short b) { return __builtin_bit_cast(float, (unsigned)b << 16); }
__device__ __forceinline__ float shfl_f(float v, int src) { return __builtin_bit_cast(float, __builtin_amdgcn_ds_bpermute(src << 2, __builtin_bit_cast(int, v))); }
__device__ __forceinline__ int shfl_i(int v, int src) { return __builtin_amdgcn_ds_bpermute(src << 2, v); }
__device__ __forceinline__ float wave_sum(float v, int lane) {
#pragma unroll
    for (int o = 1; o < 64; o <<= 1) v += shfl_f(v, lane ^ o);
    return v;
}
__device__ __forceinline__ float wave_max(float v, int lane) {
#pragma unroll
    for (int o = 1; o < 64; o <<= 1) v = fmaxf(v, shfl_f(v, lane ^ o));
    return v;
}
__device__ __forceinline__ int crow(int r, int hi) { return (r & 3) + 8 * (r >> 2) + 4 * hi; }

typedef GAS unsigned gu32;
#define RLX_AGENT __ATOMIC_RELAXED, __HIP_MEMORY_SCOPE_AGENT
#define XB_TMO      128
#define XB_XCNT(j)  (256  + 64 * (j))
#define XB_XSUB(j)  (1280 + 64 * (j))
#define XB_XGEN(j)  (2304 + 64 * (j))
#define XB_TOP      3328
#define XB_TOPGEN   3392
#define XCD_BAR_WORDS 3456
#define XB_SPIN_CAP (1u << 18)

__device__ __forceinline__ unsigned xb_ld(unsigned* p)              { return __hip_atomic_load(p, __ATOMIC_RELAXED, __HIP_MEMORY_SCOPE_AGENT); }
__device__ __forceinline__ unsigned xb_add(unsigned* p, unsigned v) { return __hip_atomic_fetch_add(p, v, __ATOMIC_RELAXED, __HIP_MEMORY_SCOPE_AGENT); }
__device__ __forceinline__ unsigned xb_xcc_id() { return (unsigned)__builtin_amdgcn_s_getreg((3 << 11) | 20) & 0xFu; }
#define XB_SPIN(cond, bar) do { unsigned _sp = 0; while (cond) { __builtin_amdgcn_s_sleep(1); \
    if ((++_sp & 255u) == 0u) { if (xb_ld(&(bar)[XB_TMO])) break; if (_sp > XB_SPIN_CAP) { atomicAdd(&(bar)[XB_TMO], 1u); break; } } } } while (0)

struct XcdBarrier {
    unsigned* bar; unsigned x;
    volatile LAS unsigned* st;
};

__device__ __forceinline__ XcdBarrier xcd_barrier_post(unsigned* bar, volatile LAS unsigned* st) {
    XcdBarrier b; b.bar = bar; b.x = xb_xcc_id(); b.st = st;
    if (threadIdx.x == 0) (void)xb_add(&bar[XB_XCNT(b.x)], 1u);
    return b;
}
__device__ __forceinline__ void xcd_barrier_complete(unsigned* bar, unsigned x, unsigned& nloc, unsigned& nx) {
    const unsigned G = gridDim.x * gridDim.y * gridDim.z;
    unsigned sum, cnt, mine, sp = 0u;
    for (;;) {
        sum = 0u; cnt = 0u; mine = 0u;
#pragma unroll
        for (unsigned j = 0; j < 16; ++j) { const unsigned c = xb_ld(&bar[XB_XCNT(j)]); sum += c; cnt += (c > 0u) ? 1u : 0u; mine = (j == x) ? c : mine; }
        if (sum == G) break;
        __builtin_amdgcn_s_sleep(1);
        if ((++sp & 255u) == 0u) { if (xb_ld(&bar[XB_TMO])) break; if (sp > XB_SPIN_CAP) { atomicAdd(&bar[XB_TMO], 1u); break; } }
    }
    nloc = mine > 0u ? mine : 1u; nx = cnt > 0u ? cnt : 1u;
}

__device__ __forceinline__ void xcd_barrier(const XcdBarrier& b) {
    asm volatile("s_waitcnt vmcnt(0)" ::: "memory");
    __syncthreads();
    if (threadIdx.x == 0) {
        unsigned* bar = b.bar;
        __builtin_amdgcn_s_waitcnt(0);
        unsigned nloc = b.st[0], nx = b.st[1];
        if (nloc == 0u) { xcd_barrier_complete(bar, b.x, nloc, nx); b.st[0] = nloc; b.st[1] = nx; }
        const unsigned old = xb_add(&bar[XB_XSUB(b.x)], 1u);
        const unsigned gen = old / nloc;
        if (old + 1u == (gen + 1u) * nloc) {
            __builtin_amdgcn_fence(__ATOMIC_RELEASE, "agent");
            asm volatile("s_waitcnt vmcnt(0)" ::: "memory");
            const unsigned og = xb_add(&bar[XB_TOP], 1u);
            const unsigned tg = og / nx;
            if (og + 1u == (tg + 1u) * nx) xb_add(&bar[XB_TOPGEN], 1u);
            else XB_SPIN(xb_ld(&bar[XB_TOPGEN]) == tg, bar);
            __builtin_amdgcn_fence(__ATOMIC_ACQUIRE, "agent");
            xb_add(&bar[XB_XGEN(b.x)], 1u);
            asm volatile("s_waitcnt vmcnt(0)" ::: "memory");
        } else {
            XB_SPIN(xb_ld(&bar[XB_XGEN(b.x)]) == gen, bar);
            __builtin_amdgcn_fence(__ATOMIC_ACQUIRE, "agent");
            asm volatile("s_waitcnt vmcnt(0)" ::: "memory");
        }
    }
    __syncthreads();
}

template <int EMU> __device__ __forceinline__ void transpose_item(const float* W, int K, int N, bf16* WT, int k0, int n0, int dst_row0, LAS float* scr, int lane) {
    float wv[32];
#pragma unroll
    for (int i = 0; i < 32; ++i) wv[i] = __builtin_nontemporal_load(W + (size_t)(k0 + 2 * i + (lane >> 5)) * N + n0 + (lane & 31));
#pragma unroll
    for (int i = 0; i < 32; ++i) { float w_ = wv[i]; if (EMU == 1) w_ = e4m3r(w_ * 32.0f) * (1.0f / 32.0f); if (EMU == 2) w_ = e4m3r(w_ * 64.0f) * (1.0f / 64.0f); scr[(2 * i + (lane >> 5)) * 33 + (lane & 31)] = w_; }
    asm volatile("s_waitcnt lgkmcnt(0)" ::: "memory");
    const int c = lane & 7;
#pragma unroll
    for (int j = 0; j < 4; ++j) { const int n = (lane >> 3) + 8 * j; const LAS float* s = scr + (8 * c) * 33 + n;
        v4u o; o.x = pk2(s[0 * 33], s[1 * 33]); o.y = pk2(s[2 * 33], s[3 * 33]); o.z = pk2(s[4 * 33], s[5 * 33]); o.w = pk2(s[6 * 33], s[7 * 33]);
        *(v4u*)(WT + (size_t)(dst_row0 + n) * K + k0 + 8 * c) = o; }
    asm volatile("s_waitcnt lgkmcnt(0)" ::: "memory");
}
__device__ __forceinline__ void transpose_item8(const float* W, int K, int N, unsigned char* WT, int k0, int n0, int dst_row0, LAS float* scr, int lane) {
    float wv[32];
#pragma unroll
    for (int i = 0; i < 32; ++i) wv[i] = __builtin_nontemporal_load(W + (size_t)(k0 + 2 * i + (lane >> 5)) * N + n0 + (lane & 31));
#pragma unroll
    for (int i = 0; i < 32; ++i) scr[(2 * i + (lane >> 5)) * 33 + (lane & 31)] = wv[i] * WGU_SCALE;
    asm volatile("s_waitcnt lgkmcnt(0)" ::: "memory");
    const int c = lane & 7;
#pragma unroll
    for (int j = 0; j < 4; ++j) { const int n = (lane >> 3) + 8 * j; const LAS float* sp = scr + (8 * c) * 33 + n;
        v2u o; o.x = pk4_fp8(sp[0 * 33], sp[1 * 33], sp[2 * 33], sp[3 * 33]); o.y = pk4_fp8(sp[4 * 33], sp[5 * 33], sp[6 * 33], sp[7 * 33]);
        *(v2u*)(WT + (size_t)(dst_row0 + n) * K + k0 + 8 * c) = o; }
    asm volatile("s_waitcnt lgkmcnt(0)" ::: "memory");
}
constexpr int CONV_SLOT = 64 * 65 * 4;
template <int OUT8>
__device__ __forceinline__ void transpose_item64(const float* W, int K, int N, void* WTv, int k0, int n0, int dst_row0, LAS float* scr, int lane) {
    f32x4 wv[16];
    const float* src = W + (size_t)(k0 + (lane >> 4)) * N + n0 + 4 * (lane & 15);
#pragma unroll
    for (int i = 0; i < 16; ++i) wv[i] = __builtin_nontemporal_load((const f32x4*)(src + (size_t)(4 * i) * N));
    LAS float* dstp = scr + (lane >> 4) * 65 + 4 * (lane & 15);
#pragma unroll
    for (int i = 0; i < 16; ++i) { const float sc_ = OUT8 == 1 ? WGU_SCALE : (OUT8 == 2 ? WD_SCALE : 1.0f); dstp[(4 * i) * 65 + 0] = wv[i].x * sc_; dstp[(4 * i) * 65 + 1] = wv[i].y * sc_; dstp[(4 * i) * 65 + 2] = wv[i].z * sc_; dstp[(4 * i) * 65 + 3] = wv[i].w * sc_; }
    asm volatile("s_waitcnt lgkmcnt(0)" ::: "memory");
    const int c = lane & 7;
#pragma unroll
    for (int j = 0; j < 8; ++j) { const int n = (lane >> 3) + 8 * j; const LAS float* sp = scr + (8 * c) * 65 + n;
        if constexpr (OUT8 != 0) { v2u o; o.x = pk4_fp8(sp[0 * 65], sp[1 * 65], sp[2 * 65], sp[3 * 65]); o.y = pk4_fp8(sp[4 * 65], sp[5 * 65], sp[6 * 65], sp[7 * 65]);
            *(v2u*)((unsigned char*)WTv + (size_t)(dst_row0 + n) * K + k0 + 8 * c) = o; }
        else { v4u o; o.x = pk2(sp[0 * 65], sp[1 * 65]); o.y = pk2(sp[2 * 65], sp[3 * 65]); o.z = pk2(sp[4 * 65], sp[5 * 65]); o.w = pk2(sp[6 * 65], sp[7 * 65]);
            *(v4u*)((bf16*)WTv + (size_t)(dst_row0 + n) * K + k0 + 8 * c) = o; } }
    asm volatile("s_waitcnt lgkmcnt(0)" ::: "memory");
}
template <int OUT8, bool GU>
__device__ __forceinline__ void convert_weights64(Frame& F, const float* W, void* WT, int nmat, int K, int N, LAS float* scr) {
    const int nblk = N / 64, kblk = K / 64, per = nblk * kblk, total = nmat * per; const size_t esz = OUT8 ? 1 : 2;
    for (int it = F.gw; it < total; it += F.NGW) {
        const int mat = it / per, r = it % per, kb = r % kblk, nb = r / kblk, n0 = nb * 64;
        int dr = n0;
        if (GU) { const int half = n0 / DFF, j0 = n0 % DFF; dr = 256 * (j0 / 128) + 128 * half + (j0 % 128); }
        transpose_item64<OUT8>(W + (size_t)mat * K * N, K, N, (unsigned char*)WT + (size_t)mat * K * N * esz, kb * 64, n0, dr, scr, F.lane);
    }
}
template <int OUT8, bool GU>
__device__ __forceinline__ void convert_stream(int gw, int ngw, int lane, const float* W, unsigned char* WT, int nmat, int K, int N, LAS float* scr) {
    const int nblk = N / 64, kblk = K / 64, per = nblk * kblk, total = nmat * per;
    const float sc_ = OUT8 == 1 ? WGU_SCALE : WD_SCALE;
    auto request = [&](f32x4 (&wv)[16], int it) {
        const int mat = it / per, r = it % per, kb = r % kblk, nb = r / kblk; const float* src = W + (size_t)mat * K * N + (size_t)(kb * 64 + (lane >> 4)) * N + nb * 64 + 4 * (lane & 15);
#pragma unroll
        for (int i = 0; i < 16; ++i) wv[i] = __builtin_nontemporal_load((const f32x4*)(src + (size_t)(4 * i) * N)); };
    auto stage = [&](const f32x4 (&wv)[16]) {
        LAS float* dstp = scr + (lane >> 4) * 65 + 4 * (lane & 15);
#pragma unroll
        for (int i = 0; i < 16; ++i) { dstp[(4 * i) * 65 + 0] = wv[i].x * sc_; dstp[(4 * i) * 65 + 1] = wv[i].y * sc_; dstp[(4 * i) * 65 + 2] = wv[i].z * sc_; dstp[(4 * i) * 65 + 3] = wv[i].w * sc_; } };
    auto finish = [&](int it) {
        const int mat = it / per, r = it % per, kb = r % kblk, nb = r / kblk, n0 = nb * 64;
        int dr = n0;
        if (GU) { const int half = n0 / DFF, j0 = n0 % DFF; dr = 256 * (j0 / 128) + 128 * half + (j0 % 128); }
        asm volatile("s_waitcnt lgkmcnt(0)" ::: "memory");
        const int c = lane & 7; unsigned char* wt = WT + (size_t)mat * K * N + kb * 64 + 8 * c;
#pragma unroll
        for (int j = 0; j < 8; ++j) { const int n = (lane >> 3) + 8 * j; const LAS float* sp = scr + (8 * c) * 65 + n;
            v2u o; o.x = pk4_fp8(sp[0 * 65], sp[1 * 65], sp[2 * 65], sp[3 * 65]); o.y = pk4_fp8(sp[4 * 65], sp[5 * 65], sp[6 * 65], sp[7 * 65]);
            *(v2u*)(wt + (size_t)(dr + n) * K) = o; }
        asm volatile("s_waitcnt lgkmcnt(0)" ::: "memory"); };
    int itA = gw, itB = gw + ngw;
    f32x4 wa[16], wb[16];
    if (itA < total) request(wa, itA);
    if (itB < total) request(wb, itB);
    while (itA < total) {
        stage(wa); { const int nx = itA + 2 * ngw; if (nx < total) request(wa, nx); finish(itA); itA = nx; }
        if (itB < total) { stage(wb); const int nx = itB + 2 * ngw; if (nx < total) request(wb, nx); finish(itB); itB = nx; }
    }
}
template <bool GU>
__device__ __forceinline__ void convert_weights8(Frame& F, const float* W, unsigned char* WT, int nmat, int K, int N, LAS float* scr) {
    const int nblk = N / 32, kblk = K / 64, per = nblk * kblk, total = nmat * per;
    for (int it = F.gw; it < total; it += F.NGW) {
        const int mat = it / per, r = it % per, kb = r / nblk, nb = r % nblk, n0 = nb * 32;
        int dr = n0;
        if (GU) { const int half = n0 / DFF, j0 = n0 % DFF; dr = 256 * (j0 / 128) + 128 * half + (j0 % 128); }
        transpose_item8(W + (size_t)mat * K * N, K, N, WT + (size_t)mat * K * N, kb * 64, n0, dr, scr, F.lane);
    }
}
template <bool GU, int EMU = 0>
__device__ __forceinline__ void convert_weights(Frame& F, const float* W, bf16* WT, int nmat, int K, int N, LAS float* scr) {
    const int nblk = N / 32, kblk = K / 64, per = nblk * kblk, total = nmat * per;
    for (int it = F.gw; it < total; it += F.NGW) {
        const int mat = it / per, r = it % per, kb = r / nblk, nb = r % nblk, n0 = nb * 32;
        int dr = n0;
        if (GU) { const int half = n0 / DFF, j0 = n0 % DFF; dr = 256 * (j0 / 128) + 128 * half + (j0 % 128); }
        transpose_item<EMU>(W + (size_t)mat * K * N, K, N, WT + (size_t)mat * K * N, kb * 64, n0, dr, scr, F.lane);
    }
}
__device__ __forceinline__ int t5_bucket(int n) {
    if (n < 16) return n;
    int l = 16 + (int)(logf((float)n / 16.0f) / logf(8.0f) * 16.0f);
    return l < 31 ? l : 31;
}
__device__ __forceinline__ void prologue_phase(Frame& F, const Args& a) {
    unsigned char* ws = a.ws;
    LAS float* scr = (LAS float*)(F.lds + F.wave * CONV_SLOT);
    const bool cvcu = CONV_CUS > 0 && (int)gridDim.x >= CONV_CUS + 64;
    if (!cvcu) convert_weights64<1, true >(F, a.in[15], ws + WS_WGU, DEPTH * NEXP, D, 2 * DFF, scr);
    else for (int l = 0; l < DEPTH; ++l) convert_weights64<1, true >(F, a.in[15] + (size_t)(l * NEXP + CONV_GU) * D * 2 * DFF, ws + WS_WGU + (size_t)(l * NEXP + CONV_GU) * D * 2 * DFF, NEXP - CONV_GU, D, 2 * DFF, scr);
    if (!cvcu) convert_weights64<2, false>(F, a.in[17], ws + WS_WD, DEPTH * NEXP, DFF, D, scr);
    convert_weights64<1, false>(F, a.in[2], ws + WS_WQKVA, 2, D, QKVA, scr);
    convert_weights64<1, false>(F, a.in[5], ws + WS_WOA, 2, D, D, scr);
    convert_weights64<1, false>(F, a.in[7], ws + WS_WQKVB, 2, D, QKVB, scr);
    convert_weights64<1, false>(F, a.in[8], ws + WS_WOB, 2, D, D, scr);
    const float* x = a.in[0]; unsigned char* xb = ws + WS_XB;
    for (int m = F.gw; m < T; m += F.NGW) {
        const f32x4* xr = (const f32x4*)(x + (size_t)m * D) + F.lane; unsigned* o = (unsigned*)(xb + (size_t)m * D) + F.lane;
#pragma unroll
        for (int j = 0; j < 4; ++j) { const f32x4 v = xr[64 * j]; o[64 * j] = pk4_fp8(v.x, v.y, v.z, v.w);
            v2u w; w.x = cvtpk(v.x, v.y); w.y = cvtpk(v.z, v.w); ((v2u*)((bf16*)(ws + WS_XF) + (size_t)m * D))[F.lane + 64 * j] = w; }
    }
    { const float* wr = a.in[13]; bf16* wt = (bf16*)(ws + WS_WRT);
      for (int idx = blockIdx.x * NTHREADS + F.tid; idx < DEPTH * NEXP * D; idx += gridDim.x * NTHREADS) {
          const int l = idx / (NEXP * D), e = (idx / D) % NEXP, k = idx % D; const float w = wr[((size_t)l * D + k) * NEXP + e];
          const unsigned h = f2bf(w); const float wl = w - __builtin_bit_cast(float, h << 16);
          wt[((size_t)(l * 2 + 0) * NEXP + e) * D + k] = (bf16)h; wt[((size_t)(l * 2 + 1) * NEXP + e) * D + k] = (bf16)f2bf(wl); } }
    if (blockIdx.x == 0) { float* bt = (float*)(ws + WS_BT); const float* rb = a.in[1];
        for (int i = F.tid; i < NH * 128; i += NTHREADS) { const int h = i >> 7, dist = i & 127; bt[i] = rb[t5_bucket(dist) * NH + h] * LOG2E; } }
}

__device__ __forceinline__ void wave_gemm2(const bf16* Arow, const bf16* B0row, const bf16* B1row, int K, f32x16& acc0, f32x16& acc1) {
    for (int k0 = 0; k0 < K; k0 += 16) {
        const bf16x8 av = *(const bf16x8*)(Arow + k0), b0 = *(const bf16x8*)(B0row + k0), b1 = *(const bf16x8*)(B1row + k0);
        acc0 = __builtin_amdgcn_mfma_f32_32x32x16_bf16(av, b0, acc0, 0, 0, 0);
        acc1 = __builtin_amdgcn_mfma_f32_32x32x16_bf16(av, b1, acc1, 0, 0, 0);
    }
}
template <class E>
__device__ __forceinline__ void gemm_dense_simple(Frame& F, const bf16* A, const bf16* Bt, int M, int N, int K, const E& epi) {
    const int ntn = N / 64, total = (M / 32) * ntn, j = F.lane & 31, h = F.lane >> 5;
    for (int it = F.gw; it < total; it += F.NGW) {
        const int tm = it / ntn, tn = it % ntn, row0 = tm * 32, col0 = tn * 64;
        f32x16 acc0 = {}, acc1 = {};
        wave_gemm2(A + (size_t)(row0 + j) * K + 8 * h, Bt + (size_t)(col0 + j) * K + 8 * h, Bt + (size_t)(col0 + 32 + j) * K + 8 * h, K, acc0, acc1);
#pragma unroll
        for (int r = 0; r < 16; ++r) { epi(row0 + crow(r, h), col0 + j, acc0[r]); epi(row0 + crow(r, h), col0 + 32 + j, acc1[r]); }
    }
}

namespace pg8 {
#define PG8_LAS __attribute__((address_space(3)))
typedef unsigned short bf16_t;
typedef short bf16x8 __attribute__((ext_vector_type(8)));
typedef float f32x4 __attribute__((ext_vector_type(4)));
typedef unsigned u32x4 __attribute__((ext_vector_type(4)));
typedef int v4i_t __attribute__((ext_vector_type(4)));
constexpr int LIST_STRIDE = 32768;
constexpr int BM = 256, BK = 64, HALF = 128, HTB = HALF * BK * 2  , STAGE_BYTES = 8 * HTB, NXCD = 8, WGM = 4;

__host__ __device__ __forceinline__ int lds_byte(int r, int c) { const int st = (r >> 4) * 2 + (c >> 5), rr = r & 15, cc = c & 31, ob = rr * 64 + cc * 2; return st * 1024 + (ob ^ (((ob >> 9) & 1) << 5)); }
__host__ __device__ __forceinline__ void stage_rc(int b, int& R, int& C) { const int st = b / 1024, sb = b % 1024, swz = sb ^ (((sb >> 9) & 1) << 5); R = (st >> 1) * 16 + swz / 64; C = (st & 1) * 32 + (swz % 64) / 2; }
__host__ __device__ __forceinline__ int perm32(int rho) { const int n = rho >> 4, i = rho & 15; return 8 * (i >> 2) + 4 * n + (i & 3); }

struct Unit { int pm, pn, e, te, cnt; };
struct Gemm { const bf16_t* A; const bf16_t* Bt; int M, N, K; size_t bstride; const int* list; int sb_off; };

struct StaticOrder {
    int nM, nN, nwg, G, c;
    __host__ __device__ void init(int M, int N, int G_, int c_) { nM = M / BM; nN = N / BM; nwg = nM * nN; G = G_; c = c_; }
    __host__ __device__ bool next(int i, Unit& u) const {
        const long L = (long)i * G + c; if (L >= nwg) return false;
        int wgid = (int)L; { const int q = nwg / NXCD, r = nwg % NXCD, xcd = wgid % NXCD, off = wgid / NXCD; wgid = (xcd < r ? xcd * (q + 1) : r * (q + 1) + (xcd - r) * q) + off; }
        const int nig = WGM * nN, gid = wgid / nig, fm = gid * WGM, gsz = (nM - fm) < WGM ? (nM - fm) : WGM;
        u.pm = fm + ((wgid % nig) % gsz); u.pn = (wgid % nig) / gsz; u.e = 0; u.te = 0; u.cnt = 0; return true;
    }
    __host__ __device__ bool next_lane(int i, Unit& u) const { return next(i, u); }
    __device__ __forceinline__ void a_ready(const Unit&) const {}
    __device__ __forceinline__ void done(const Unit&) const {}
};

__device__ __forceinline__ unsigned cvt_pk_bf16(float lo, float hi) { unsigned r; asm volatile("v_cvt_pk_bf16_f32 %0, %1, %2" : "=v"(r) : "v"(lo), "v"(hi)); return r; }
typedef float f32x2 __attribute__((ext_vector_type(2)));
__device__ __forceinline__ f32x2 gelu_pk(f32x2 v) {
    const f32x2 av = __builtin_elementwise_abs(v), d = av * 0.2316418882f + 1.0f;
    f32x2 t; t.x = __builtin_amdgcn_rcpf(d.x); t.y = __builtin_amdgcn_rcpf(d.y);
    f32x2 q = t * 0.5307027145f + (-0.7265760135f); q = q * t + 0.7107068705f; q = q * t + (-0.142248368f); q = q * t + 0.127414796f; q = q * t;
    const f32x2 s = (v * v) * (-0.72134752044f);
    f32x2 e; e.x = __builtin_amdgcn_exp2f(s.x); e.y = __builtin_amdgcn_exp2f(s.y);
    const f32x2 m = v * (q * e), r = v - m;
    f32x2 o; o.x = v.x < 0.f ? m.x : r.x; o.y = v.y < 0.f ? m.y : r.y; return o;
}

template <int ACT  > struct EpiBf16 {
    static constexpr bool PERM = true, AFTER_DRAIN = false; static constexpr int NSB = 1; static_assert(ACT == 0 || ACT == 1, "EpiBf16: ACT is 0 (none) or 1 (gelu_pk)");
    __device__ __forceinline__ const void* sb_src(const Unit& u, int, int lane) const { return bias ? (const void*)(bias + u.pn * BM + lane * 4) : nullptr; }
    bf16_t* O; int ldc; const float* bias; int split_cols; size_t split_stride; float scale0; float wsc;
    __device__ __forceinline__ void operator()(const f32x4 (&acc)[2][2][4][2], const Unit& u, int wr, int wc, int fr, int fq, const PG8_LAS float* sb) const {
        const int row0 = u.pm * BM + wr * 64 + fr; int colt = u.pn * BM; bf16_t* base = O;
        float sc = 1.f; if (split_cols) { const int t = colt / split_cols; base += (size_t)t * split_stride; colt -= t * split_cols; if (t == 0) sc = scale0; }
        const int col0 = colt + wc * 32 + 8 * fq, bcol0 = u.pn * BM + wc * 32 + 8 * fq;
        f32x4 bv[2][2];
#pragma unroll
        for (int bj = 0; bj < 2; ++bj)
#pragma unroll
            for (int n = 0; n < 2; ++n) bv[bj][n] = bias ? *(const PG8_LAS f32x4*)(sb + wc * 32 + 8 * fq + bj * HALF + 4 * n) : (f32x4){0.f, 0.f, 0.f, 0.f};
        (void)bcol0;
#pragma unroll
        for (int ai = 0; ai < 2; ++ai)
#pragma unroll
            for (int m = 0; m < 4; ++m) { bf16_t* rowp = base + (size_t)(row0 + ai * HALF + m * 16) * ldc + col0;
#pragma unroll
                for (int bj = 0; bj < 2; ++bj) { f32x4 v0 = acc[ai][bj][m][0] * wsc + bv[bj][0], v1 = acc[ai][bj][m][1] * wsc + bv[bj][1];
                    if (ACT == 1) { f32x2 a = gelu_pk((f32x2){v0[0], v0[1]}), b = gelu_pk((f32x2){v0[2], v0[3]}), c = gelu_pk((f32x2){v1[0], v1[1]}), d = gelu_pk((f32x2){v1[2], v1[3]});
                        v0 = (f32x4){a.x, a.y, b.x, b.y}; v1 = (f32x4){c.x, c.y, d.x, d.y}; }
                    v0 = v0 * sc; v1 = v1 * sc; u32x4 w; w.x = cvt_pk_bf16(v0[0], v0[1]); w.y = cvt_pk_bf16(v0[2], v0[3]); w.z = cvt_pk_bf16(v1[0], v1[1]); w.w = cvt_pk_bf16(v1[2], v1[3]);
                    *(__attribute__((address_space(1))) u32x4*)(rowp + bj * HALF) = w; } }
    }
};
template <class Epi, class Sched, bool ALIGN_EPI = false, bool SP2 = false, bool GATHER = false, bool FP8 = false>
__device__ __forceinline__ void gemm_phase(PG8_LAS unsigned char* lds, const Gemm g, const Sched& S, const Epi& E) {
    int tid_ = threadIdx.x; asm volatile("" : "+v"(tid_));
    const int tid = tid_, wid = __builtin_amdgcn_readfirstlane(tid >> 6), lane = tid & 63, wr = wid >> 2, wc = wid & 3, fr = lane & 15, fq = lane >> 4;
    const int K = g.K, nt = K / BK;
    static_assert(!GATHER || SP2, "GATHER is wired into the SP2 loop only");
    unsigned voffA[2], voffB[2]; int gR[2]; unsigned gC[2];
#pragma unroll
    for (int i = 0; i < 2; ++i) { int R, C; stage_rc(tid * 16 + i * 8192, R, C); const int Rb = Epi::PERM ? ((R & ~31) + perm32(R & 31)) : R;
        voffA[i] = (unsigned)(R * K + C) * 2u; voffB[i] = (unsigned)(Rb * K + C) * 2u; gR[i] = R; gC[i] = (unsigned)C * 2u; }
    unsigned vA[2][2] = {{0u, 0u}, {0u, 0u}}; int tokN[2][2] = {{0, 0}, {0, 0}};
#define PG8_TOK(u_, h_, i_) (g.list ? (((u_).te * 256 + (h_) * 128 + gR[i_]) < (u_).cnt ? g.list[(size_t)(u_).e * LIST_STRIDE + (u_).te * 256 + (h_) * 128 + gR[i_]] : 0) : ((u_).pm * 256 + (h_) * 128 + gR[i_]))
    const size_t kstep = (size_t)(BK * 2);
    const size_t hstep = (size_t)HALF * K * 2;
    const size_t tstep = 2 * hstep;
    const unsigned ldsw = (unsigned)wid * 1024u;
    const int aoff = lds_byte(wr * 64 + fr, fq * 8), boff = lds_byte(wc * 32 + fr, fq * 8);
#define PG8_SA(b, h) (((b) * 2 + (h)) * HTB)
#define PG8_SB(b, h) ((4 + (b) * 2 + (h)) * HTB)
#define PG8_STAGE(bufoff, gbase, voff) do { _Pragma("unroll") for (int _i = 0; _i < 2; ++_i) \
        __builtin_amdgcn_global_load_lds((const unsigned*)((const char*)(gbase) + (voff)[_i]), (PG8_LAS unsigned*)(lds + (bufoff) + ldsw + _i * 8192), 16, 0, 0); } while (0)
#define PG8_GL16(gp, ldsoff) __builtin_amdgcn_global_load_lds((const unsigned*)(gp), (PG8_LAS unsigned*)(lds + (ldsoff)), 16, 0, 0)
#define PG8_STAGE_A(bufoff, gbase, h, NX) do { if constexpr (GATHER) { \
        PG8_GL16((const char*)(gbase) + vA[h][0], (bufoff) + ldsw); PG8_GL16((const char*)(gbase) + vA[h][1], (bufoff) + ldsw + 8192); } \
    else { PG8_STAGE(bufoff, (gbase) + (h) * hstep, voffA); } } while (0)
#define PG8_LDA(dst, b, h) do { _Pragma("unroll") for (int m = 0; m < 4; ++m) _Pragma("unroll") for (int k = 0; k < 2; ++k) dst[m][k] = *(const PG8_LAS bf16x8*)(lds + PG8_SA(b, h) + aoff + m * 2048 + k * 1024); } while (0)
#define PG8_LDB(dst, b, h) do { _Pragma("unroll") for (int n = 0; n < 2; ++n) _Pragma("unroll") for (int k = 0; k < 2; ++k) dst[n][k] = *(const PG8_LAS bf16x8*)(lds + PG8_SB(b, h) + boff + n * 2048 + k * 1024); } while (0)
#define PG8_CAT8(x0, x1) __builtin_shufflevector(__builtin_bit_cast(v4i_t, x0), __builtin_bit_cast(v4i_t, x1), 0, 1, 2, 3, 4, 5, 6, 7)
#define PG8_MMA(ai, bj, At, Bt) do { __builtin_amdgcn_s_setprio(1); if constexpr (FP8) { _Pragma("unroll") for (int m = 0; m < 4; ++m) _Pragma("unroll") for (int n = 0; n < 2; ++n) \
        acc[ai][bj][m][n] = __builtin_amdgcn_mfma_scale_f32_16x16x128_f8f6f4(PG8_CAT8(Bt[n][0], Bt[n][1]), PG8_CAT8(At[m][0], At[m][1]), acc[ai][bj][m][n], 0, 0, 0, 0x7F7F7F7F, 0, 0x7F7F7F7F); } \
    else { _Pragma("unroll") for (int m = 0; m < 4; ++m) _Pragma("unroll") for (int n = 0; n < 2; ++n) _Pragma("unroll") for (int k = 0; k < 2; ++k) \
        acc[ai][bj][m][n] = __builtin_amdgcn_mfma_f32_16x16x32_bf16(Bt[n][k], At[m][k], acc[ai][bj][m][n], 0, 0, 0); } __builtin_amdgcn_s_setprio(0); } while (0)
#define PG8_WAIT_V(n) asm volatile("s_waitcnt vmcnt(" #n ")" ::: "memory")
#define PG8_WAIT_L(n) asm volatile("s_waitcnt lgkmcnt(" #n ")" ::: "memory")
#define PG8_BAR __builtin_amdgcn_s_barrier()
#define PG8_SCHED __builtin_amdgcn_sched_barrier(0)
    Unit cur, nxt; int ui = 0;
    PG8_LAS int* utab = (PG8_LAS int*)(lds + g.sb_off + 2 * 3072);
    __syncthreads();
    if (tid < 32) { Unit u_; u_.pm = u_.pn = u_.e = u_.te = u_.cnt = 0; const bool ok_ = S.next_lane(tid, u_); PG8_LAS int* r_ = utab + tid * 8; r_[0] = ok_ ? 1 : 0; r_[1] = u_.pm; r_[2] = u_.pn; r_[3] = u_.e; r_[4] = u_.te; r_[5] = u_.cnt; }
    __syncthreads();
#define PG8_UNIT(i_, u_) ((i_) < 32 ? ((__builtin_amdgcn_readfirstlane(utab[(i_) * 8]) != 0) ? ((u_).pm = __builtin_amdgcn_readfirstlane(utab[(i_) * 8 + 1]), (u_).pn = __builtin_amdgcn_readfirstlane(utab[(i_) * 8 + 2]), (u_).e = __builtin_amdgcn_readfirstlane(utab[(i_) * 8 + 3]), \
        (u_).te = __builtin_amdgcn_readfirstlane(utab[(i_) * 8 + 4]), (u_).cnt = __builtin_amdgcn_readfirstlane(utab[(i_) * 8 + 5]), true) : false) : S.next((i_), (u_)))
    if (!PG8_UNIT(0, cur)) return;
    f32x4 acc[2][2][4][2];
#pragma unroll
    for (int a = 0; a < 2; ++a)
#pragma unroll
        for (int b = 0; b < 2; ++b)
#pragma unroll
            for (int m = 0; m < 4; ++m)
#pragma unroll
                for (int n = 0; n < 2; ++n) acc[a][b][m][n] = (f32x4){0.f, 0.f, 0.f, 0.f};
    bf16x8 At[4][2], B0[2][2], B1[2][2];
    const char* cA = (const char*)g.A + (GATHER ? (size_t)0 : (size_t)cur.pm * tstep); const char* cB = (const char*)g.Bt + (size_t)cur.pn * tstep + (size_t)cur.e * g.bstride;
    if constexpr (GATHER) {
#pragma unroll
        for (int h = 0; h < 2; ++h)
#pragma unroll
            for (int i = 0; i < 2; ++i) vA[h][i] = (unsigned)PG8_TOK(cur, h, i) * (unsigned)(K * 2) + gC[i];
    }
    S.a_ready(cur);
    if constexpr (SP2) {
        PG8_STAGE(PG8_SB(0, 0), cB, voffB); PG8_STAGE(PG8_SB(0, 1), cB + hstep, voffB); PG8_STAGE_A(PG8_SA(0, 0), cA, 0, false); PG8_STAGE_A(PG8_SA(0, 1), cA, 1, false);
        if (wr == 1) PG8_BAR;
        PG8_WAIT_V(2); PG8_BAR;
        PG8_STAGE(PG8_SB(1, 0), cB + kstep, voffB); PG8_STAGE_A(PG8_SA(1, 0), cA + kstep, 0, false); PG8_STAGE(PG8_SB(1, 1), cB + hstep + kstep, voffB);
        PG8_WAIT_V(6); PG8_BAR;
    } else {
        PG8_STAGE(PG8_SB(0, 0), cB, voffB); PG8_STAGE(PG8_SA(0, 0), cA, voffA); PG8_STAGE(PG8_SB(0, 1), cB + hstep, voffB); PG8_STAGE(PG8_SA(0, 1), cA + hstep, voffA);
        if (wr == 1) PG8_BAR;
        PG8_WAIT_V(4); PG8_BAR;
        PG8_STAGE(PG8_SB(1, 0), cB + kstep, voffB); PG8_STAGE(PG8_SA(1, 0), cA + kstep, voffA); PG8_STAGE(PG8_SB(1, 1), cB + hstep + kstep, voffB);
        PG8_WAIT_V(6); PG8_BAR;
    }
    for (;;) {
        const bool has_next = PG8_UNIT(ui + 1, nxt);
        const char* nA = (has_next && !GATHER) ? (const char*)g.A + (size_t)nxt.pm * tstep : cA; const char* nB = has_next ? (const char*)g.Bt + (size_t)nxt.pn * tstep + (size_t)nxt.e * g.bstride : cB;

        if constexpr (Epi::NSB > 0) {
#pragma unroll
            for (int k = 0; k < Epi::NSB; ++k) if (wid == k) { const void* src_ = E.sb_src(cur, k, lane); if (src_) PG8_GL16(src_, g.sb_off + (ui & 1) * 3072 + k * 1024); } }
        if constexpr (GATHER) { if (has_next) {
#pragma unroll
            for (int h = 0; h < 2; ++h)
#pragma unroll
                for (int i = 0; i < 2; ++i) tokN[h][i] = PG8_TOK(nxt, h, i); } }
#pragma nounroll
        for (int t = 0; t < nt; t += 2) {
            const bool last = (t == nt - 2);
            const char* a1 = cA + (size_t)(t + 1) * kstep;
            const char* a2 = last ? nA : cA + (size_t)(t + 2) * kstep; const char* b2 = last ? nB : cB + (size_t)(t + 2) * kstep;
            const char* a3 = a2 + kstep; const char* b3 = b2 + kstep;
            if (last && has_next) S.a_ready(nxt);
            if constexpr (SP2) {
            PG8_LDB(B0, 0, 0); PG8_LDB(B1, 0, 1); PG8_SCHED; PG8_LDA(At, 0, 0); PG8_STAGE_A(PG8_SA(1, 1), a1, 1, false);
            if constexpr (GATHER) { if (last && has_next) {
#pragma unroll
                for (int h = 0; h < 2; ++h)
#pragma unroll
                    for (int i = 0; i < 2; ++i) vA[h][i] = (unsigned)tokN[h][i] * (unsigned)(K * 2) + gC[i]; } }
            PG8_WAIT_V(8); PG8_WAIT_L(0); PG8_BAR; PG8_MMA(0, 0, At, B0); PG8_MMA(0, 1, At, B1); PG8_BAR; PG8_SCHED;
            PG8_LDA(At, 0, 1); PG8_STAGE(PG8_SB(0, 0), b2, voffB); PG8_STAGE(PG8_SB(0, 1), b2 + hstep, voffB); PG8_STAGE_A(PG8_SA(0, 0), a2, 0, last);
            PG8_WAIT_V(8); PG8_WAIT_L(0); PG8_BAR; PG8_MMA(1, 0, At, B0); PG8_MMA(1, 1, At, B1); PG8_BAR; PG8_SCHED;
            PG8_LDB(B0, 1, 0); PG8_LDB(B1, 1, 1); PG8_SCHED; PG8_LDA(At, 1, 0); PG8_STAGE_A(PG8_SA(0, 1), a2, 1, last);
            PG8_WAIT_V(8); PG8_WAIT_L(0); PG8_BAR; PG8_MMA(0, 0, At, B0); PG8_MMA(0, 1, At, B1); PG8_BAR; PG8_SCHED;
            PG8_LDA(At, 1, 1); PG8_STAGE(PG8_SB(1, 0), b3, voffB); PG8_STAGE(PG8_SB(1, 1), b3 + hstep, voffB); PG8_STAGE_A(PG8_SA(1, 0), a3, 0, last);
            PG8_WAIT_V(8); PG8_WAIT_L(0); PG8_BAR; PG8_MMA(1, 0, At, B0); PG8_MMA(1, 1, At, B1); PG8_BAR; PG8_SCHED;
            } else {
            PG8_LDB(B0, 0, 0); PG8_SCHED; PG8_LDA(At, 0, 0); PG8_STAGE(PG8_SA(1, 1), a1 + hstep, voffA);
            PG8_WAIT_L(8); PG8_BAR; PG8_WAIT_L(0); PG8_MMA(0, 0, At, B0); PG8_BAR; PG8_SCHED;
            PG8_LDB(B1, 0, 1); PG8_STAGE(PG8_SB(0, 0), b2, voffB);
            PG8_BAR; PG8_WAIT_L(0); PG8_MMA(0, 1, At, B1); PG8_BAR;
            PG8_LDA(At, 0, 1); PG8_STAGE(PG8_SA(0, 0), a2, voffA);
            PG8_BAR; PG8_WAIT_L(0); PG8_MMA(1, 0, At, B0); PG8_BAR; PG8_SCHED;
            PG8_STAGE(PG8_SB(0, 1), b2 + hstep, voffB);
            PG8_WAIT_V(6); PG8_BAR; PG8_MMA(1, 1, At, B1); PG8_BAR;
            PG8_LDB(B0, 1, 0); PG8_SCHED; PG8_LDA(At, 1, 0); PG8_STAGE(PG8_SA(0, 1), a2 + hstep, voffA);
            PG8_WAIT_L(8); PG8_BAR; PG8_WAIT_L(0); PG8_MMA(0, 0, At, B0); PG8_BAR; PG8_SCHED;
            PG8_LDB(B1, 1, 1); PG8_STAGE(PG8_SB(1, 0), b3, voffB);
            PG8_BAR; PG8_WAIT_L(0); PG8_MMA(0, 1, At, B1); PG8_BAR;
            PG8_LDA(At, 1, 1); PG8_STAGE(PG8_SA(1, 0), a3, voffA);
            PG8_BAR; PG8_WAIT_L(0); PG8_MMA(1, 0, At, B0); PG8_BAR; PG8_SCHED;
            PG8_STAGE(PG8_SB(1, 1), b3 + hstep, voffB);
            PG8_WAIT_V(6); PG8_BAR; PG8_MMA(1, 1, At, B1); PG8_BAR;
            }
        }
        if constexpr (ALIGN_EPI) { if (wr == 0) PG8_BAR; }
        if constexpr (!Epi::AFTER_DRAIN) { E(acc, cur, wr, wc, fr, fq, (const PG8_LAS float*)(lds + g.sb_off + (ui & 1) * 3072)); S.done(cur); }
        if (!has_next) break;
#pragma unroll
        for (int a = 0; a < 2; ++a)
#pragma unroll
            for (int b = 0; b < 2; ++b)
#pragma unroll
                for (int m = 0; m < 4; ++m)
#pragma unroll
                    for (int n = 0; n < 2; ++n) acc[a][b][m][n] = (f32x4){0.f, 0.f, 0.f, 0.f};
        cur = nxt; cA = nA; cB = nB; ++ui;

        if constexpr (ALIGN_EPI) { if (wr == 1) PG8_BAR; }
    }
    PG8_WAIT_V(0);
    if constexpr (!ALIGN_EPI) { if (wr == 0) PG8_BAR; }
    PG8_BAR;
    if constexpr (Epi::AFTER_DRAIN) { E.fused(acc, cur, wr, wc, fr, fq, lds, wid, lane); S.done(cur); }
#undef PG8_SA
#undef PG8_SB
#undef PG8_STAGE
#undef PG8_LDA
#undef PG8_STAGE_A
#undef PG8_GL16
#undef PG8_TOK
#undef PG8_UNIT
#undef PG8_LDB
#undef PG8_MMA
#undef PG8_CAT8
#undef PG8_WAIT_V
#undef PG8_WAIT_L
#undef PG8_BAR
#undef PG8_SCHED
}

struct EpiZ {
    static constexpr bool PERM = false, AFTER_DRAIN = false; static constexpr int NSB = 0;
    float* Z; const float* xres; const float* bias; int ldc; float alpha; float wsc;
    __device__ __forceinline__ void operator()(const f32x4 (&acc)[2][2][4][2], const Unit& u, int wr, int wc, int fr, int fq, const PG8_LAS float*) const {
        const int row0 = u.pm * BM + wr * 64 + fr, col0 = u.pn * BM + wc * 32 + 4 * fq;
        f32x4 bv[2][2];
#pragma unroll
        for (int bj = 0; bj < 2; ++bj)
#pragma unroll
            for (int n = 0; n < 2; ++n) bv[bj][n] = bias ? *(const f32x4*)(bias + col0 + bj * HALF + n * 16) : (f32x4){0.f, 0.f, 0.f, 0.f};
#pragma unroll
        for (int ai = 0; ai < 2; ++ai)
#pragma unroll
            for (int mp = 0; mp < 2; ++mp) {
                f32x4 xr[2][2][2];
#pragma unroll
                for (int mm = 0; mm < 2; ++mm) { const size_t off = (size_t)(row0 + ai * HALF + (2 * mp + mm) * 16) * ldc + col0;
#pragma unroll
                    for (int bj = 0; bj < 2; ++bj)
#pragma unroll
                        for (int n = 0; n < 2; ++n) xr[mm][bj][n] = *(const __attribute__((address_space(1))) f32x4*)(xres + off + bj * HALF + n * 16); }
#pragma unroll
                for (int mm = 0; mm < 2; ++mm) { const int m = 2 * mp + mm; const size_t off = (size_t)(row0 + ai * HALF + m * 16) * ldc + col0;
#pragma unroll
                    for (int bj = 0; bj < 2; ++bj)
#pragma unroll
                        for (int n = 0; n < 2; ++n) *(__attribute__((address_space(1))) f32x4*)(Z + off + bj * HALF + n * 16) = bf16r4(acc[ai][bj][m][n] * wsc + bv[bj][n] + xr[mm][bj][n] * alpha); }
                asm volatile("" ::: "memory");
            }
    }
};
struct EpiZ16 {
    static constexpr bool PERM = true, AFTER_DRAIN = false; static constexpr int NSB = 1;
    bf16_t* Z; const bf16_t* xres; const float* bias; int ldc; float alpha; float wsc;
    __device__ __forceinline__ const void* sb_src(const Unit& u, int, int lane) const { return bias ? (const void*)(bias + u.pn * BM + lane * 4) : nullptr; }
    __device__ __forceinline__ void operator()(const f32x4 (&acc)[2][2][4][2], const Unit& u, int wr, int wc, int fr, int fq, const PG8_LAS float* sb) const {
        const int row0 = u.pm * BM + wr * 64 + fr, col0 = u.pn * BM + wc * 32 + 8 * fq;
        f32x4 bv[2][2];
#pragma unroll
        for (int bj = 0; bj < 2; ++bj)
#pragma unroll
            for (int n = 0; n < 2; ++n) bv[bj][n] = bias ? *(const PG8_LAS f32x4*)(sb + wc * 32 + 8 * fq + bj * HALF + 4 * n) : (f32x4){0.f, 0.f, 0.f, 0.f};
#pragma unroll
        for (int ai = 0; ai < 2; ++ai) {
            u32x4 xr[4][2];
#pragma unroll
            for (int m = 0; m < 4; ++m)
#pragma unroll
                for (int bj = 0; bj < 2; ++bj) xr[m][bj] = *(const __attribute__((address_space(1))) u32x4*)(xres + (size_t)(row0 + ai * HALF + m * 16) * ldc + col0 + bj * HALF);
#pragma unroll
            for (int m = 0; m < 4; ++m)
#pragma unroll
                for (int bj = 0; bj < 2; ++bj) { const u32x4 x = xr[m][bj];
                    const f32x4 x0 = {__builtin_bit_cast(float, x.x << 16), __builtin_bit_cast(float, x.x & 0xffff0000u), __builtin_bit_cast(float, x.y << 16), __builtin_bit_cast(float, x.y & 0xffff0000u)};
                    const f32x4 x1 = {__builtin_bit_cast(float, x.z << 16), __builtin_bit_cast(float, x.z & 0xffff0000u), __builtin_bit_cast(float, x.w << 16), __builtin_bit_cast(float, x.w & 0xffff0000u)};
                    const f32x4 v0 = acc[ai][bj][m][0] * wsc + bv[bj][0] + x0 * alpha, v1 = acc[ai][bj][m][1] * wsc + bv[bj][1] + x1 * alpha;
                    u32x4 w; w.x = cvt_pk_bf16(v0[0], v0[1]); w.y = cvt_pk_bf16(v0[2], v0[3]); w.z = cvt_pk_bf16(v1[0], v1[1]); w.w = cvt_pk_bf16(v1[2], v1[3]);
                    *(__attribute__((address_space(1))) u32x4*)(Z + (size_t)(row0 + ai * HALF + m * 16) * ldc + col0 + bj * HALF) = w; }
        }
    }
};
__device__ __forceinline__ float swiglu1(float g, float u) {
    g = fminf(g, 7.0f); u = fminf(fmaxf(u, -7.0f), 7.0f);
    const float s = __builtin_amdgcn_rcpf(1.0f + __builtin_amdgcn_exp2f(g * (-1.702f * 1.4426950408889634f)));
    const float a_ = (u + 1.0f) * (g * s);
    return (FP8_EMU & 2) ? e4m3r(a_) : a_;
}
__device__ __forceinline__ f32x2 swiglu2s(f32x2 g, f32x2 u) {
    g.x = fminf(g.x, 7.0f); g.y = fminf(g.y, 7.0f);
    u.x = __builtin_amdgcn_fmed3f(u.x, -7.0f, 7.0f); u.y = __builtin_amdgcn_fmed3f(u.y, -7.0f, 7.0f);
    const f32x2 t = g * (-1.702f * 1.4426950408889634f);
    f32x2 d; d.x = __builtin_amdgcn_exp2f(t.x); d.y = __builtin_amdgcn_exp2f(t.y);
    d = d + 1.0f;
    f32x2 sg; sg.x = __builtin_amdgcn_rcpf(d.x); sg.y = __builtin_amdgcn_rcpf(d.y);
    const f32x2 up = u * ACT_SCALE + ACT_SCALE;
    return up * (g * sg);
}
struct EpiSwiglu {
    static constexpr bool PERM = true, AFTER_DRAIN = false; static constexpr int NSB = 1;
    __device__ __forceinline__ const void* sb_src(const Unit& u, int, int lane) const {
        return (const void*)(bgu + (size_t)u.e * 2048 + (lane >> 5) * 1024 + u.pn * HALF + (lane & 31) * 4); }
    bf16_t* ACT; const float* bgu; float wsc;
    __device__ __forceinline__ void operator()(const f32x4 (&acc)[2][2][4][2], const Unit& u, int wr, int wc, int fr, int fq, const PG8_LAS float* sb) const {
        const int row0 = u.pm * BM + wr * 64 + fr, j0 = u.pn * HALF + wc * 32 + 8 * fq;
        const PG8_LAS float* bg = sb + wc * 32 + 8 * fq;
        const f32x4 g0 = *(const PG8_LAS f32x4*)bg, g1 = *(const PG8_LAS f32x4*)(bg + 4), u0 = *(const PG8_LAS f32x4*)(bg + 128), u1 = *(const PG8_LAS f32x4*)(bg + 132);
#pragma unroll
        for (int ai = 0; ai < 2; ++ai)
#pragma unroll
            for (int m = 0; m < 4; ++m) { unsigned char* rowp = (unsigned char*)ACT + (size_t)(row0 + ai * HALF + m * 16) * 1024 + j0;
                const f32x4 ga = acc[ai][0][m][0] * wsc + g0, gb = acc[ai][0][m][1] * wsc + g1, ua = acc[ai][1][m][0] * wsc + u0, ub = acc[ai][1][m][1] * wsc + u1;
                const f32x2 a0 = swiglu2s((f32x2){ga[0], ga[1]}, (f32x2){ua[0], ua[1]}), a1 = swiglu2s((f32x2){ga[2], ga[3]}, (f32x2){ua[2], ua[3]});
                const f32x2 a2 = swiglu2s((f32x2){gb[0], gb[1]}, (f32x2){ub[0], ub[1]}), a3 = swiglu2s((f32x2){gb[2], gb[3]}, (f32x2){ub[2], ub[3]});
                v2u w; w.x = pk4_fp8(a0.x, a0.y, a1.x, a1.y); w.y = pk4_fp8(a2.x, a2.y, a3.x, a3.y);
                *(__attribute__((address_space(1))) v2u*)rowp = w; }
    }
};
struct EpiDown {
    static constexpr bool PERM = true, AFTER_DRAIN = false; static constexpr int NSB = 3;
    __device__ __forceinline__ const void* sb_src(const Unit& u, int k, int lane) const {
        return k == 0 ? (const void*)(bd + (size_t)u.e * 1024 + u.pn * BM + lane * 4) : k == 1 ? (const void*)(sgate + (size_t)u.e * LIST_STRIDE + u.te * BM + lane * 4)
                                                                                                   : (const void*)(listk + (size_t)u.e * LIST_STRIDE + u.te * BM + lane * 4); }
    const int* listk;
    bf16_t* Y; const float* bd; const float* sgate; float wsc;
    __device__ __forceinline__ void operator()(const f32x4 (&acc)[2][2][4][2], const Unit& u, int wr, int wc, int fr, int fq, const PG8_LAS float* sb) const {
        const int col0 = u.pn * BM + wc * 32 + 8 * fq;
        f32x4 bv[2][2];
#pragma unroll
        for (int bj = 0; bj < 2; ++bj)
#pragma unroll
            for (int n = 0; n < 2; ++n) bv[bj][n] = *(const PG8_LAS f32x4*)(sb + wc * 32 + 8 * fq + bj * HALF + 4 * n);
        float gts[2][4];
#pragma unroll
        for (int ai = 0; ai < 2; ++ai)
#pragma unroll
            for (int m = 0; m < 4; ++m) gts[ai][m] = sb[256 + wr * 64 + fr + ai * HALF + m * 16];
        int dst[2][4];
#pragma unroll
        for (int ai = 0; ai < 2; ++ai)
#pragma unroll
            for (int m = 0; m < 4; ++m) { const int rl = wr * 64 + fr + ai * HALF + m * 16; dst[ai][m] = (u.te * BM + rl) < u.cnt ? ((const PG8_LAS int*)sb)[512 + rl] : -1; }
#pragma unroll
        for (int ai = 0; ai < 2; ++ai)
#pragma unroll
            for (int m = 0; m < 4; ++m) { if (dst[ai][m] < 0) continue; const float gt = gts[ai][m] * Y_SCALE; unsigned char* rowp = (unsigned char*)Y + (size_t)dst[ai][m] * 1024 + col0;
#pragma unroll
                for (int bj = 0; bj < 2; ++bj) { const f32x4 v0 = (acc[ai][bj][m][0] * wsc + bv[bj][0]) * gt, v1 = (acc[ai][bj][m][1] * wsc + bv[bj][1]) * gt;
                    v2u w; w.x = pk4_fp8(v0[0], v0[1], v0[2], v0[3]); w.y = pk4_fp8(v1[0], v1[1], v1[2], v1[3]);
                    *(__attribute__((address_space(1))) v2u*)(rowp + bj * HALF) = w; } }
    }
};
struct MoeOrder {
    StaticOrder so; const PG8_LAS int* t_e; const PG8_LAS int* t_te; const PG8_LAS int* t_cnt;
    __device__ void init(int nmt, int N, int G_, int c_, const PG8_LAS int* te_, const PG8_LAS int* tte_, const PG8_LAS int* tc_) { so.init(nmt * BM, N, G_, c_); t_e = te_; t_te = tte_; t_cnt = tc_; }
    __device__ bool next(int i, Unit& u) const { if (!so.next(i, u)) return false;
        u.e = __builtin_amdgcn_readfirstlane(t_e[u.pm]); u.te = __builtin_amdgcn_readfirstlane(t_te[u.pm]); u.cnt = __builtin_amdgcn_readfirstlane(t_cnt[u.e]); return true; }
    __device__ bool next_lane(int i, Unit& u) const { if (!so.next(i, u)) return false; u.e = t_e[u.pm]; u.te = t_te[u.pm]; u.cnt = t_cnt[u.e]; return true; }
    __device__ __forceinline__ void a_ready(const Unit&) const {}
    __device__ __forceinline__ void done(const Unit&) const {}
};
}

template <int CTRL> __device__ __forceinline__ float dpp_f(float v) { return __builtin_bit_cast(float, __builtin_amdgcn_update_dpp(0, __builtin_bit_cast(int, v), CTRL, 0xF, 0xF, true)); }
template <int CTRL> __device__ __forceinline__ int dpp_i(int v) { return __builtin_amdgcn_update_dpp(0, v, CTRL, 0xF, 0xF, true); }
__device__ __forceinline__ float g16_max(float v, int) {
    v = fmaxf(v, dpp_f<0xB1>(v)); v = fmaxf(v, dpp_f<0x4E>(v)); v = fmaxf(v, dpp_f<0x141>(v)); v = fmaxf(v, dpp_f<0x140>(v)); return v;
}
__device__ __forceinline__ int g16_min(int v, int) {
    int t = dpp_i<0xB1>(v); v = t < v ? t : v; t = dpp_i<0x4E>(v); v = t < v ? t : v; t = dpp_i<0x141>(v); v = t < v ? t : v; t = dpp_i<0x140>(v); v = t < v ? t : v; return v;
}
__device__ __forceinline__ void ln1_router_phase(Frame& F, const bf16* Z, const float* g, const float* b, const bf16* Wr2, const float* br,
                                                 bf16* X1, unsigned char* X18, int* TOPE, float* TOPG, int* POS, unsigned* CNT, int* LIST, float* LGATE, int* LISTK, int ln_only = 0) {
    const int lane = F.lane, tk = lane & 15, kg = lane >> 4;
    LAS unsigned* hist = (LAS unsigned*)F.lds;
    const int nrounds = (T + F.NGW * 16 - 1) / (F.NGW * 16);
    for (int rd_ = 0; rd_ < nrounds; ++rd_) {
        const int t0 = (rd_ * F.NGW + F.gw) * 16; const bool live = t0 < T;
        if (F.tid < 32) hist[F.tid] = 0u;
        __syncthreads();
        int ex_r[4]; float gt_r[4]; unsigned lp_r[4];
        if (live) {
        if (ln_only != 3)
        {
            float gv[2][8], bv[2][8];
#pragma unroll
            for (int j = 0; j < 2; ++j)
#pragma unroll
                for (int e = 0; e < 8; ++e) { gv[j][e] = g[8 * (lane + 64 * j) + e]; bv[j][e] = b[8 * (lane + 64 * j) + e]; }
#pragma unroll 4
            for (int tt = 0; tt < 16; ++tt) {
                const size_t m = (size_t)(t0 + tt);
                const GAS v4u* zr = (const GAS v4u*)(Z + m * D) + lane;
                float v[2][8]; unpack8(zr[0], v[0]); unpack8(zr[64], v[1]);
                float s = 0.f;
#pragma unroll
                for (int j = 0; j < 2; ++j)
#pragma unroll
                    for (int e = 0; e < 8; ++e) s += v[j][e];
                const float mean = wave_sum(s, lane) * (1.f / D); float s2 = 0.f;
#pragma unroll
                for (int j = 0; j < 2; ++j)
#pragma unroll
                    for (int e = 0; e < 8; ++e) { v[j][e] -= mean; s2 += v[j][e] * v[j][e]; }
                const float rstd = 1.0f / sqrtf(wave_sum(s2, lane) * (1.f / D) + LN_EPS);
#pragma unroll
                for (int j = 0; j < 2; ++j) {
#pragma unroll
                    for (int e = 0; e < 8; ++e) v[j][e] = v[j][e] * rstd * gv[j][e] + bv[j][e];
                    v2u w8; w8.x = pk4_fp8(v[j][0], v[j][1], v[j][2], v[j][3]); w8.y = pk4_fp8(v[j][4], v[j][5], v[j][6], v[j][7]);
                    ((GAS v2u*)(X18 + m * D))[lane + 64 * j] = w8; }
                if (lane == 0) { f32x2_t st_; st_.x = mean; st_.y = rstd; *(GAS f32x2_t*)((float*)X1 + 2 * m) = st_; *(LAS f32x2_t*)(F.lds + 512 + F.wave * 128 + 8 * tt) = st_; }
            }
        }
        asm volatile("s_waitcnt vmcnt(0)" ::: "memory");
        f32x4 a0 = {0.f, 0.f, 0.f, 0.f}, a1 = {0.f, 0.f, 0.f, 0.f};
        if (ln_only != 1) {
        const GAS bf16* zrow = (const GAS bf16*)(Z + (size_t)(t0 + tk) * D + 8 * kg);
        f32x2_t st_; if (ln_only == 0) st_ = *(const LAS f32x2_t*)(F.lds + 512 + F.wave * 128 + 8 * tk); else st_ = *(const GAS f32x2_t*)((const float*)X1 + 2 * (size_t)(t0 + tk));
        const float mean_ = st_.x, rstd_ = st_.y;
        const GAS float* gk = (const GAS float*)(g + 8 * kg); const GAS float* bk = (const GAS float*)(b + 8 * kg);
        const GAS bf16* wh = (const GAS bf16*)(Wr2 + (size_t)tk * D + 8 * kg); const GAS bf16* wl = wh + (size_t)NEXP * D;
#pragma unroll 4
        for (int ks = 0; ks < 32; ++ks) {
            bf16x8 xh;
            { float zv[8]; unpack8(*(const GAS v4u*)(zrow + 32 * ks), zv);
              const f32x4 g0_ = *(const GAS f32x4*)(gk + 32 * ks), g1_ = *(const GAS f32x4*)(gk + 32 * ks + 4), b0_ = *(const GAS f32x4*)(bk + 32 * ks), b1_ = *(const GAS f32x4*)(bk + 32 * ks + 4);
#pragma unroll
              for (int e = 0; e < 8; ++e) { const float d_ = zv[e] - mean_; zv[e] = d_ * rstd_ * (e < 4 ? g0_[e & 3] : g1_[e & 3]) + (e < 4 ? b0_[e & 3] : b1_[e & 3]); }
              xh = __builtin_bit_cast(bf16x8, pack8(zv)); }
            const bf16x8 bh0 = *(const GAS bf16x8*)(wh + 32 * ks), bh1 = *(const GAS bf16x8*)(wh + 16 * D + 32 * ks), bl0 = *(const GAS bf16x8*)(wl + 32 * ks), bl1 = *(const GAS bf16x8*)(wl + 16 * D + 32 * ks);
            a0 = __builtin_amdgcn_mfma_f32_16x16x32_bf16(xh, bh0, a0, 0, 0, 0); a1 = __builtin_amdgcn_mfma_f32_16x16x32_bf16(xh, bh1, a1, 0, 0, 0);
            a0 = __builtin_amdgcn_mfma_f32_16x16x32_bf16(xh, bl0, a0, 0, 0, 0); a1 = __builtin_amdgcn_mfma_f32_16x16x32_bf16(xh, bl1, a1, 0, 0, 0);
        }
        }
        const float b0 = br[tk], b1 = br[16 + tk];
        if (ln_only == 1) { ex_r[0] = ex_r[1] = ex_r[2] = ex_r[3] = 0; }
        else if (ln_only == 2) { if (a0[0] + a1[1] + a0[2] + a1[3] == 1.2345f) TOPG[t0] = a0[1]; }
        else
#pragma unroll
        for (int r = 0; r < 4; ++r) {
            float v0 = a0[r] + b0, v1 = a1[r] + b1;
            float tv[4]; int ti[4];
#pragma unroll
            for (int rd = 0; rd < 4; ++rd) {
                const float gm = g16_max(fmaxf(v0, v1), lane);
                const int cand = (v0 == gm) ? tk : ((v1 == gm) ? 16 + tk : 64);
                const int gi = g16_min(cand, lane);
                tv[rd] = gm; ti[rd] = gi; if (gi == tk) v0 = -INFINITY; if (gi == 16 + tk) v1 = -INFINITY;
            }
            const float e1 = __expf(tv[1] - tv[0]), e2 = __expf(tv[2] - tv[0]), e3 = __expf(tv[3] - tv[0]);
            const float inv = 1.0f / (1.0f + e1 + e2 + e3);
            ex_r[r] = tk == 0 ? ti[0] : tk == 1 ? ti[1] : tk == 2 ? ti[2] : ti[3];
            gt_r[r] = (tk == 0 ? 1.0f : tk == 1 ? e1 : tk == 2 ? e2 : e3) * inv;
            lp_r[r] = 0u;
            if (tk < 4) lp_r[r] = __hip_atomic_fetch_add(hist + ex_r[r], 1u, __ATOMIC_RELAXED, __HIP_MEMORY_SCOPE_WORKGROUP);
        }
        }
        __syncthreads();
        if (F.tid < 32) { const unsigned c = hist[F.tid]; hist[32 + F.tid] = c ? atomicAdd(CNT + F.tid * CNT_STRIDE, c) : 0u; }
        __syncthreads();
        if (live && tk < 4 && ln_only != 1) {
#pragma unroll
            for (int r = 0; r < 4; ++r) { const size_t a = (size_t)(t0 + 4 * kg + r) * 4 + tk;
                const int pos = (int)(hist[32 + ex_r[r]] + lp_r[r]);
                TOPE[a] = ex_r[r]; TOPG[a] = gt_r[r]; POS[a] = pos; LIST[(size_t)ex_r[r] * T + pos] = t0 + 4 * kg + r; LGATE[(size_t)ex_r[r] * T + pos] = gt_r[r]; LISTK[(size_t)ex_r[r] * T + pos] = (t0 + 4 * kg + r) * 4 + tk; }
        }
        __syncthreads();
    }
}

__device__ __forceinline__ void moe_tables(Frame& F, const unsigned* CNT) {
    const int lane = F.lane;
    LAS int* pst = (LAS int*)(F.lds + LT_PSTART); LAS int* pcn = (LAS int*)(F.lds + LT_CNT); LAS int* pen = (LAS int*)(F.lds + LT_SB);
    __syncthreads();
    if (F.wave == 0) {
        const unsigned c = lane < 32 ? __hip_atomic_load(CNT + (lane & 31) * CNT_STRIDE, __ATOMIC_RELAXED, __HIP_MEMORY_SCOPE_AGENT) : 0u;
        const int padded = (int)((c + 255u) & ~255u);
        int incl = padded;
#pragma unroll
        for (int o = 1; o < 32; o <<= 1) { const int t = shfl_i(incl, (lane - o) & 63); if ((lane & 31) >= o) incl += t; }
        if (lane < 32) { pst[lane] = incl - padded; pcn[lane] = (int)c; pen[lane] = incl; }
        if (lane == 31) ((LAS int*)(F.lds + LT_NMT))[0] = incl >> 8;
    }
    __syncthreads();
    for (int mt = F.tid; mt < MAXMT; mt += NTHREADS) {
        int ee = 0;
#pragma unroll 8
        for (int q = 0; q < 32; ++q) ee += (pen[q] <= mt * 256) ? 1 : 0;
        ee = ee < 31 ? ee : 31;
        ((LAS int*)(F.lds + LT_E))[mt] = ee; ((LAS int*)(F.lds + LT_TE))[mt] = mt - (pst[ee] >> 8);
    }
    __syncthreads();
}

__device__ __forceinline__ void ln2_phase(Frame& F, const bf16* __restrict__ X1  , const float* __restrict__ STATS, const float* __restrict__ g1, const float* __restrict__ b1, const bf16* __restrict__ Y, const int* __restrict__ TOPE, const int* __restrict__ POS, const float* __restrict__ g, const float* __restrict__ b,
                                          bf16* __restrict__ XR, float* __restrict__ OUT, unsigned char* __restrict__ XB, bool last_layer) {
    const int lane = F.lane;
    float gv[2][8], bv[2][8];
#pragma unroll
    for (int j = 0; j < 2; ++j)
#pragma unroll
        for (int e = 0; e < 8; ++e) { gv[j][e] = g[8 * (lane + 64 * j) + e]; bv[j][e] = b[8 * (lane + 64 * j) + e]; }
    float gv1[2][8], bv1[2][8];
#pragma unroll
    for (int j = 0; j < 2; ++j)
#pragma unroll
        for (int e = 0; e < 8; ++e) { gv1[j][e] = g1[8 * (lane + 64 * j) + e]; bv1[j][e] = b1[8 * (lane + 64 * j) + e]; }
    for (int tok0 = F.gw; tok0 < T; tok0 += 2 * F.NGW) {
        float v[2][2][8]; v2u yw[2][4][2];
#pragma unroll
        for (int q = 0; q < 2; ++q) { const int tok = tok0 + q * F.NGW; if (tok < T) {
            const GAS v4u* xr = (const GAS v4u*)(X1 + (size_t)tok * D) + lane; const v4u x0 = xr[0], x1 = xr[64];
#pragma unroll
            for (int r = 0; r < 4; ++r) { const GAS v2u* yr = (const GAS v2u*)((const unsigned char*)Y + (size_t)(tok * 4 + r) * D) + lane; yw[q][r][0] = __builtin_nontemporal_load(yr); yw[q][r][1] = __builtin_nontemporal_load(yr + 64); }
            unpack8(x0, v[q][0]); unpack8(x1, v[q][1]);
            const f32x2_t st_ = *(const GAS f32x2_t*)(STATS + 2 * (size_t)tok);
#pragma unroll
            for (int j = 0; j < 2; ++j) {
#pragma unroll
                for (int e = 0; e < 8; ++e) { const float d_ = v[q][j][e] - st_.x; v[q][j][e] = d_ * st_.y * gv1[j][e] + bv1[j][e]; }
                unpack8(pack8(v[q][j]), v[q][j]); } } }
#pragma unroll
        for (int q = 0; q < 2; ++q) { const int tok = tok0 + q * F.NGW; if (tok < T) {
#pragma unroll
            for (int j = 0; j < 2; ++j)
#pragma unroll
                for (int e = 0; e < 8; ++e) v[q][j][e] *= DN_ALPHA;
#pragma unroll
            for (int r = 0; r < 4; ++r)
#pragma unroll
                for (int j = 0; j < 2; ++j) { const v2u w = yw[q][r][j];
                    const f32x2_t a0 = __builtin_amdgcn_cvt_pk_f32_fp8((int)w.x, false), a1 = __builtin_amdgcn_cvt_pk_f32_fp8((int)w.x, true), a2 = __builtin_amdgcn_cvt_pk_f32_fp8((int)w.y, false), a3 = __builtin_amdgcn_cvt_pk_f32_fp8((int)w.y, true);
                    v[q][j][0] += a0.x * (1.0f / Y_SCALE); v[q][j][1] += a0.y * (1.0f / Y_SCALE); v[q][j][2] += a1.x * (1.0f / Y_SCALE); v[q][j][3] += a1.y * (1.0f / Y_SCALE);
                    v[q][j][4] += a2.x * (1.0f / Y_SCALE); v[q][j][5] += a2.y * (1.0f / Y_SCALE); v[q][j][6] += a3.x * (1.0f / Y_SCALE); v[q][j][7] += a3.y * (1.0f / Y_SCALE); }
            float s = 0.f;
#pragma unroll
            for (int j = 0; j < 2; ++j)
#pragma unroll
                for (int e = 0; e < 8; ++e) s += v[q][j][e];
            const float mean = wave_sum(s, lane) * (1.f / D); float s2 = 0.f;
#pragma unroll
            for (int j = 0; j < 2; ++j)
#pragma unroll
                for (int e = 0; e < 8; ++e) { v[q][j][e] -= mean; s2 += v[q][j][e] * v[q][j][e]; }
            const float rstd = 1.0f / sqrtf(wave_sum(s2, lane) * (1.f / D) + LN_EPS);
#pragma unroll
            for (int j = 0; j < 2; ++j) {
#pragma unroll
                for (int e = 0; e < 8; ++e) v[q][j][e] = v[q][j][e] * rstd * gv[j][e] + bv[j][e];
                if (last_layer) { GAS f32x4* of = (GAS f32x4*)(OUT + (size_t)tok * D + 8 * (lane + 64 * j));
                    of[0] = (f32x4){v[q][j][0], v[q][j][1], v[q][j][2], v[q][j][3]}; of[1] = (f32x4){v[q][j][4], v[q][j][5], v[q][j][6], v[q][j][7]}; }
                else {
                    ((GAS v4u*)(XR + (size_t)tok * D))[lane + 64 * j] = pack8(v[q][j]);
                    v2u w8; w8.x = pk4_fp8(v[q][j][0], v[q][j][1], v[q][j][2], v[q][j][3]); w8.y = pk4_fp8(v[q][j][4], v[q][j][5], v[q][j][6], v[q][j][7]);
                    ((GAS v2u*)(XB + (size_t)tok * D))[lane + 64 * j] = w8; }
            } } }
    }
}

__device__ __forceinline__ float dot64(const float (&q)[64], const bf16* krow) {
    float s = 0.f;
#pragma unroll
    for (int c = 0; c < 8; ++c) { const v4u kv = *(const v4u*)(krow + 8 * c);
        s += q[8 * c + 0] * __builtin_bit_cast(float, kv.x << 16) + q[8 * c + 1] * __builtin_bit_cast(float, kv.x & 0xffff0000u)
           + q[8 * c + 2] * __builtin_bit_cast(float, kv.y << 16) + q[8 * c + 3] * __builtin_bit_cast(float, kv.y & 0xffff0000u)
           + q[8 * c + 4] * __builtin_bit_cast(float, kv.z << 16) + q[8 * c + 5] * __builtin_bit_cast(float, kv.z & 0xffff0000u)
           + q[8 * c + 6] * __builtin_bit_cast(float, kv.w << 16) + q[8 * c + 7] * __builtin_bit_cast(float, kv.w & 0xffff0000u); }
    return s;
}
__device__ __forceinline__ void load_q64(float (&q)[64], const bf16* qrow) {
#pragma unroll
    for (int c = 0; c < 8; ++c) { const v4u kv = *(const v4u*)(qrow + 8 * c);
        q[8 * c + 0] = __builtin_bit_cast(float, kv.x << 16); q[8 * c + 1] = __builtin_bit_cast(float, kv.x & 0xffff0000u);
        q[8 * c + 2] = __builtin_bit_cast(float, kv.y << 16); q[8 * c + 3] = __builtin_bit_cast(float, kv.y & 0xffff0000u);
        q[8 * c + 4] = __builtin_bit_cast(float, kv.z << 16); q[8 * c + 5] = __builtin_bit_cast(float, kv.z & 0xffff0000u);
        q[8 * c + 6] = __builtin_bit_cast(float, kv.w << 16); q[8 * c + 7] = __builtin_bit_cast(float, kv.w & 0xffff0000u); }
}
__device__ __forceinline__ void swa_simple_phase(Frame& F, const bf16* QKV, const float* BT, const float* sinks, bf16* O) {
    const int lane = F.lane;
    for (int item = F.gw; item < T * NH; item += F.NGW) {
        const int tok = item >> 4, hq = item & 15, t = tok & (SEQ - 1), kvh = hq >> 3;
        float q[64]; load_q64(q, QKV + (size_t)tok * QKVA + hq * HD);
        const bf16* kbase = QKV + 1024 + kvh * HD; const bf16* vbase = QKV + 1152 + kvh * HD;
        const bool v0 = (t - lane) >= 0, v1 = (t - 64 - lane) >= 0;
        float s0 = -INFINITY, s1 = -INFINITY;
        if (v0) s0 = dot64(q, kbase + (size_t)(tok - lane) * QKVA) + BT[hq * 128 + lane];
        if (v1) s1 = dot64(q, kbase + (size_t)(tok - 64 - lane) * QKVA) + BT[hq * 128 + 64 + lane];
        const float sk = sinks[hq] * LOG2E;
        const float m = fmaxf(wave_max(fmaxf(s0, s1), lane), sk);
        float p0 = v0 ? exp2f(s0 - m) : 0.f, p1 = v1 ? exp2f(s1 - m) : 0.f;
        const float den = wave_sum(p0 + p1, lane) + exp2f(sk - m);
        p0 /= den; p1 /= den;
        float o = 0.f;
        for (int j = 0; j < 64; ++j) { const float pj = shfl_f(p0, j); if (t - j >= 0) o += pj * bf2f(vbase[(size_t)(tok - j) * QKVA + lane]); }
        for (int j = 0; j < 64; ++j) { const float pj = shfl_f(p1, j); if (t - 64 - j >= 0) o += pj * bf2f(vbase[(size_t)(tok - 64 - j) * QKVA + lane]); }
        O[(size_t)tok * D + hq * HD + lane] = (bf16)f2bf(o);
    }
}
__device__ __forceinline__ void sb_simple_phase(Frame& F, const bf16* QKV, bf16* O) {
    const int lane = F.lane;
    for (int item = F.gw; item < T * NH; item += F.NGW) {
        const int tok = item >> 4, hh = item & 15, t = tok & (SEQ - 1);
        float q[64]; load_q64(q, QKV + (size_t)tok * QKVB + hh * HD);
        const bf16* kbase = QKV + 1024 + hh * HD; const bf16* vbase = QKV + 2048 + hh * HD;
        float carry = 0.f, o = 0.f;
        for (int c0 = t - 1; c0 >= 0; c0 -= 64) {
            const int key = c0 - lane; const bool valid = key >= 0;
            float z2 = 0.f; if (valid) z2 = dot64(q, kbase + (size_t)(tok - t + key) * QKVB);
            const float sp = fmaxf(z2, 0.f) + log2f(1.0f + exp2f(-fabsf(z2)));
            const float L = valid ? -sp : 0.f;
            float incl = L;
#pragma unroll
            for (int ofs = 1; ofs < 64; ofs <<= 1) { const float tmp = shfl_f(incl, (lane - ofs) & 63); if (lane >= ofs) incl += tmp; }
            const float w = valid ? exp2f((z2 - sp) + carry + (incl - L)) : 0.f;
            carry += shfl_f(incl, 63);
            for (int j = 0; j < 64; ++j) { const float wj = shfl_f(w, j); if (c0 - j >= 0) o += wj * bf2f(vbase[(size_t)(tok - t + c0 - j) * QKVB + lane]); }
            if (carry < SB_EXIT) break;
        }
        O[(size_t)tok * D + hh * HD + lane] = (bf16)f2bf(o);
    }
}


typedef short v4i16_t __attribute__((ext_vector_type(4)));

__device__ __forceinline__ float other_half(float x, int hi) {
    auto rr = __builtin_amdgcn_permlane32_swap(__builtin_bit_cast(unsigned, x), __builtin_bit_cast(unsigned, x), false, false);
    return __builtin_bit_cast(float, hi ? rr[0] : rr[1]);
}
__device__ __forceinline__ bf16x8 vfrag(const LAS unsigned char* p) {
    const v4i16_t lo = __builtin_amdgcn_ds_read_tr16_b64_v4i16((LAS v4i16_t*)p), hi = __builtin_amdgcn_ds_read_tr16_b64_v4i16((LAS v4i16_t*)(p + 512));
    return (bf16x8){lo[0], lo[1], lo[2], lo[3], hi[0], hi[1], hi[2], hi[3]};
}
__device__ __forceinline__ bf16x8 pfrag(const f32x16& p, int s8) {
    v4u w; w.x = cvtpk(p[s8 + 0], p[s8 + 1]); w.y = cvtpk(p[s8 + 2], p[s8 + 3]); w.z = cvtpk(p[s8 + 4], p[s8 + 5]); w.w = cvtpk(p[s8 + 6], p[s8 + 7]);
    return __builtin_bit_cast(bf16x8, w);
}
__device__ __forceinline__ void load_k_tile(bf16x8 (&kr)[2][4], const bf16* Kh, size_t pitch, int kv0, int lane) {
    const bf16* kp = Kh + (size_t)(kv0 + (lane >> 3)) * pitch + 8 * (lane & 7);
#pragma unroll
    for (int i = 0; i < 8; ++i) kr[i >> 2][i & 3] = *(const GAS bf16x8*)(kp + (size_t)(8 * i) * pitch);
}
__device__ __forceinline__ void k_frags_via_lds(bf16x8 (&kf)[2][4], const bf16x8 (&kr)[2][4], LAS unsigned char* img, int lane) {
    const int rw = lane >> 3, cw = lane & 7;
#pragma unroll
    for (int i = 0; i < 8; ++i) *(LAS bf16x8*)(img + (8 * i + rw) * 128 + ((cw ^ rw) * 16)) = kr[i >> 2][i & 3];
    const int rr = lane & 31, hi = lane >> 5;
#pragma unroll
    for (int hf = 0; hf < 2; ++hf)
#pragma unroll
        for (int d0 = 0; d0 < 4; ++d0) kf[hf][d0] = *(const LAS bf16x8*)(img + (32 * hf + rr) * 128 + (((2 * d0 + hi) ^ (rr & 7)) * 16));
}
__device__ __forceinline__ void load_v_tile(v4u (&vr)[8], const bf16* Vh, size_t pitch, int kv0, int lane) {
    const bf16* vp = Vh + (size_t)(kv0 + (lane >> 3)) * pitch + 8 * (lane & 7);
#pragma unroll
    for (int i = 0; i < 8; ++i) vr[i] = *(const GAS v4u*)(vp + (size_t)(8 * i) * pitch);
}
__device__ __forceinline__ void store_v_tile(const v4u (&vr)[8], LAS unsigned char* vimg, int lane) {
    const int rw = lane >> 3, c = lane & 7;
#pragma unroll
    for (int i = 0; i < 8; ++i) *(LAS v4u*)(vimg + (c >> 2) * 4096 + (8 * i + rw) * 64 + (c & 3) * 16) = vr[i];
}
__device__ __forceinline__ void qk_tile(f32x16& p0, f32x16& p1, const bf16x8 (&kf)[2][4], const bf16x8 (&qf)[4]) {
    p0 = (f32x16){}; p1 = (f32x16){};
#pragma unroll
    for (int d0 = 0; d0 < 4; ++d0) { p0 = __builtin_amdgcn_mfma_f32_32x32x16_bf16(kf[0][d0], qf[d0], p0, 0, 0, 0); p1 = __builtin_amdgcn_mfma_f32_32x32x16_bf16(kf[1][d0], qf[d0], p1, 0, 0, 0); }
}
__device__ __forceinline__ void qk_half(f32x16& p, const bf16x8 (&kfh)[4], const bf16x8 (&qf)[4]) {
    p = (f32x16){};
#pragma unroll
    for (int d0 = 0; d0 < 4; ++d0) p = __builtin_amdgcn_mfma_f32_32x32x16_bf16(kfh[d0], qf[d0], p, 0, 0, 0);
}
template <int HF> __device__ __forceinline__ void pv_half(f32x16 (&o)[2], const f32x16& p, const LAS unsigned char* vtr) {
#pragma unroll
    for (int d0 = 0; d0 < 2; ++d0) {
        o[d0] = __builtin_amdgcn_mfma_f32_32x32x16_bf16(vfrag(vtr + d0 * 4096 + (2 * HF + 0) * 1024), pfrag(p, 0), o[d0], 0, 0, 0);
        o[d0] = __builtin_amdgcn_mfma_f32_32x32x16_bf16(vfrag(vtr + d0 * 4096 + (2 * HF + 1) * 1024), pfrag(p, 8), o[d0], 0, 0, 0);
    }
}
__device__ __forceinline__ void pv_tile(f32x16 (&o)[2], const f32x16& p0, const f32x16& p1, const LAS unsigned char* vtr) {
#pragma unroll
    for (int d0 = 0; d0 < 2; ++d0) {
        o[d0] = __builtin_amdgcn_mfma_f32_32x32x16_bf16(vfrag(vtr + d0 * 4096 + 0 * 1024), pfrag(p0, 0), o[d0], 0, 0, 0);
        o[d0] = __builtin_amdgcn_mfma_f32_32x32x16_bf16(vfrag(vtr + d0 * 4096 + 1 * 1024), pfrag(p0, 8), o[d0], 0, 0, 0);
        o[d0] = __builtin_amdgcn_mfma_f32_32x32x16_bf16(vfrag(vtr + d0 * 4096 + 2 * 1024), pfrag(p1, 0), o[d0], 0, 0, 0);
        o[d0] = __builtin_amdgcn_mfma_f32_32x32x16_bf16(vfrag(vtr + d0 * 4096 + 3 * 1024), pfrag(p1, 8), o[d0], 0, 0, 0);
    }
}
constexpr float O_SCALE = 16.0f;
__device__ __forceinline__ void store_o(const f32x16 (&o)[2], float sc, unsigned char* Orow  , int hi) {
    sc *= O_SCALE;
#pragma unroll
    for (int d0 = 0; d0 < 2; ++d0)
#pragma unroll
        for (int g = 0; g < 4; ++g) *(unsigned*)(Orow + 32 * d0 + 8 * g + 4 * hi) = pk4_fp8(o[d0][4 * g] * sc, o[d0][4 * g + 1] * sc, o[d0][4 * g + 2] * sc, o[d0][4 * g + 3] * sc);
}
__device__ __forceinline__ void load_q_frag(bf16x8 (&q)[4], const bf16* qp) {
#pragma unroll
    for (int d0 = 0; d0 < 4; ++d0) q[d0] = *(const GAS bf16x8*)(qp + 16 * d0);
}
__device__ __forceinline__ void swa_phase(Frame& F, const bf16* QKV, const float* BT, const float* sinks, unsigned char* O) {
    const int lane = F.lane, ql = lane & 31, hi = lane >> 5;
    LAS unsigned char* vimg = F.lds + F.wave * 16384;
    LAS float* tb = (LAS float*)(vimg + 8192);
    const LAS unsigned char* vtr = vimg + ((lane >> 4) & 1) * 32 + (lane & 3) * 8 + (4 * hi + ((lane & 15) >> 2)) * 64;
    constexpr int NITEMS = (T / 32) * NH;
    int item = F.gw; if (item >= NITEMS) return;
    int hq_tb = -1;
    bf16x8 qf[4]; bf16x8 kfn[2][4]; v4u vrn[8];
    { const int blk = item >> 4, hq = item & 15, kvh = hq >> 3, bb = blk >> 8, r0 = (blk & 255) * 32; const size_t tok0 = (size_t)bb * SEQ;
      const bf16* Kh = QKV + tok0 * QKVA + 1024 + kvh * HD; const int tmax = (r0 + 31) >> 6;
      load_q_frag(qf, QKV + (tok0 + r0 + ql) * QKVA + hq * HD + 8 * hi); load_k_tile(kfn, Kh, QKVA, tmax * 64, lane); load_v_tile(vrn, Kh + 128, QKVA, tmax * 64, lane); }
    for (;;) {
        const int blk = item >> 4, hq = item & 15, kvh = hq >> 3, bb = blk >> 8, r0 = (blk & 255) * 32;
        const size_t tok0 = (size_t)bb * SEQ;
        if (hq != hq_tb) { for (int i = lane; i < 320; i += 64) { const int dist = i - 96; tb[i] = (dist >= 0 && dist < 128) ? BT[hq * 128 + dist] : -INFINITY; } hq_tb = hq; }
        const bf16* Kh = QKV + tok0 * QKVA + 1024 + kvh * HD; const bf16* Vh = Kh + 128;
        const float sk = sinks[hq] * LOG2E;
        float m = sk, l = 0.f; f32x16 o[2]; o[0] = (f32x16){}; o[1] = (f32x16){};
        const int tmax = (r0 + 31) >> 6; int tmin = (r0 - 127) >> 6; if (tmin < 0) tmin = 0;
        const int item2 = item + F.NGW; const bool has2 = item2 < NITEMS;
        const int blkb = item2 >> 4, hqb = item2 & 15, bbb = blkb >> 8, r0b = (blkb & 255) * 32; const size_t tok0b = (size_t)bbb * SEQ;
        const bf16* Khb = QKV + tok0b * QKVA + 1024 + (hqb >> 3) * HD; const int tmaxb = (r0b + 31) >> 6;
        for (int t = tmax; t >= tmin; --t) {
            const int kv0 = t * 64;
            bf16x8 kf[2][4];
            k_frags_via_lds(kf, kfn, vimg, lane);
            store_v_tile(vrn, vimg, lane);
            if (t > tmin) { load_k_tile(kfn, Kh, QKVA, kv0 - 64, lane); load_v_tile(vrn, Vh, QKVA, kv0 - 64, lane); }
            else if (has2) { load_k_tile(kfn, Khb, QKVA, tmaxb * 64, lane); load_v_tile(vrn, Khb + 128, QKVA, tmaxb * 64, lane); }
            const bool sk0 = kv0 + 31 < r0 - 127, sk1 = kv0 + 32 > r0 + 31;
            f32x16 p0 = {}, p1 = {};
            if (!sk0) qk_half(p0, kf[0], qf);
            if (!sk1) qk_half(p1, kf[1], qf);
            if (t == tmin && has2) load_q_frag(qf, QKV + (tok0b + r0b + ql) * QKVA + hqb * HD + 8 * hi);
            const LAS float* tp = tb + (96 + r0 + ql - kv0 - 4 * hi - 59);
            float mx = -INFINITY;
            if (!sk0) {
#pragma unroll
                for (int r = 0; r < 16; ++r) { p0[r] += tp[59 - ((r & 3) + 8 * (r >> 2))]; mx = fmaxf(mx, p0[r]); } }
            if (!sk1) {
#pragma unroll
                for (int r = 0; r < 16; ++r) { p1[r] += tp[27 - ((r & 3) + 8 * (r >> 2))]; mx = fmaxf(mx, p1[r]); } }
            mx = fmaxf(mx, other_half(mx, hi));
            const float mn = fmaxf(m, mx), alpha = __builtin_amdgcn_exp2f(m - mn); m = mn;
            float ls = 0.f;
            if (!sk0) {
#pragma unroll
                for (int r = 0; r < 16; ++r) { p0[r] = __builtin_amdgcn_exp2f(p0[r] - mn); ls += p0[r]; } }
            if (!sk1) {
#pragma unroll
                for (int r = 0; r < 16; ++r) { p1[r] = __builtin_amdgcn_exp2f(p1[r] - mn); ls += p1[r]; } }
            l = l * alpha + ls;
#pragma unroll
            for (int r = 0; r < 16; ++r) { o[0][r] *= alpha; o[1][r] *= alpha; }
            if (!sk0) pv_half<0>(o, p0, vtr);
            if (!sk1) pv_half<1>(o, p1, vtr);
        }
        const float den = l + other_half(l, hi) + __builtin_amdgcn_exp2f(sk - m);
        store_o(o, 1.0f / den, O + (tok0 + r0 + ql) * D + hq * HD, hi);
        if (!has2) break;
        item = item2;
    }
}
__device__ __forceinline__ void sb_phase(Frame& F, const bf16* QKV, unsigned char* O) {
    const int lane = F.lane, ql = lane & 31, hi = lane >> 5;
    LAS unsigned char* vimg = F.lds + F.wave * 16384;
    const LAS unsigned char* vtr = vimg + ((lane >> 4) & 1) * 32 + (lane & 3) * 8 + (4 * hi + ((lane & 15) >> 2)) * 64;
    constexpr int NITEMS = (T / 32) * NH;
    int item = F.gw; if (item >= NITEMS) return;
    bf16x8 qf[4]; bf16x8 kfn[2][4]; v4u vrn[8];
    { const int hh = item >> 10, blk = item & 1023, bb = blk >> 8, r0 = (blk & 255) * 32; const size_t tok0 = (size_t)bb * SEQ;
      const bf16* Kh = QKV + tok0 * QKVB + 1024 + hh * HD; const int tmax = (r0 + 31) >> 6;
      load_q_frag(qf, QKV + (tok0 + r0 + ql) * QKVB + hh * HD + 8 * hi); load_k_tile(kfn, Kh, QKVB, tmax * 64, lane); load_v_tile(vrn, Kh + 1024, QKVB, tmax * 64, lane); }
    for (;;) {
        const int hh = item >> 10, blk = item & 1023, bb = blk >> 8, r0 = (blk & 255) * 32;
        const size_t tok0 = (size_t)bb * SEQ;
        const bf16* Kh = QKV + tok0 * QKVB + 1024 + hh * HD; const bf16* Vh = Kh + 1024;
        float cpos = 0.f; f32x16 o[2]; o[0] = (f32x16){}; o[1] = (f32x16){};
        const int tmax = (r0 + 31) >> 6, qabs = r0 + ql;
        const int item2 = item + F.NGW; const bool has2 = item2 < NITEMS;
#define SB_NEXT_DECODE() int i2_ = item2; asm volatile("" : "+s"(i2_));   \
        const int hhb = i2_ >> 10, blkb = i2_ & 1023, bbb = blkb >> 8, r0b = (blkb & 255) * 32; const size_t tok0b = (size_t)bbb * SEQ; \
        const bf16* Khb = QKV + tok0b * QKVB + 1024 + hhb * HD; const int tmaxb = (r0b + 31) >> 6; (void)tmaxb; (void)Khb;
        bool have = true;
        bool nextq = false;
        for (int t = tmax; t >= 0; --t) {
            const int kv0 = t * 64;
            bf16x8 kf[2][4];
            if (!have) { load_k_tile(kfn, Kh, QKVB, kv0, lane); load_v_tile(vrn, Vh, QKVB, kv0, lane); nextq = false; }
            k_frags_via_lds(kf, kfn, vimg, lane);
            store_v_tile(vrn, vimg, lane);
            bool have_next = false;
            if (t == tmax && t > 0) { load_k_tile(kfn, Kh, QKVB, kv0 - 64, lane); load_v_tile(vrn, Vh, QKVB, kv0 - 64, lane); have_next = true; }
            else if (!nextq && has2) { SB_NEXT_DECODE(); load_k_tile(kfn, Khb, QKVB, tmaxb * 64, lane); load_v_tile(vrn, Khb + 1024, QKVB, tmaxb * 64, lane); nextq = true; }
            f32x16 p0, p1; qk_tile(p0, p1, kf, qf);
            f32x16 s0, s1;
            const bool diag = (t == tmax);
#pragma unroll
            for (int r = 0; r < 16; ++r) {
                { const float z = p0[r], sp = fmaxf(z, 0.f) + __builtin_amdgcn_logf(1.0f + __builtin_amdgcn_exp2f(-fabsf(z))); s0[r] = sp; p0[r] = z - sp; }
                { const float z = p1[r], sp = fmaxf(z, 0.f) + __builtin_amdgcn_logf(1.0f + __builtin_amdgcn_exp2f(-fabsf(z))); s1[r] = sp; p1[r] = z - sp; }
            }
            if (diag) {
#pragma unroll
                for (int r = 0; r < 16; ++r) { const int kv = kv0 + crow(r, hi);
                    if (kv >= qabs) { s0[r] = 0.f; p0[r] = -INFINITY; }
                    if (kv + 32 >= qabs) { s1[r] = 0.f; p1[r] = -INFINITY; } }
            }
            float T8[9];
#pragma unroll
            for (int mI = 0; mI < 8; ++mI) { const f32x16& sv = mI < 4 ? s0 : s1; const int b = 4 * (mI & 3); T8[mI] = (sv[b + 3] + sv[b + 2]) + (sv[b + 1] + sv[b]); }
            T8[8] = 0.f;
#pragma unroll
            for (int mI = 6; mI >= 0; --mI) T8[mI] += T8[mI + 1];
            float U8[9];
#pragma unroll
            for (int mI = 0; mI < 8; ++mI) U8[mI] = other_half(T8[mI], hi);
            U8[8] = 0.f;
#pragma unroll
            for (int mI = 0; mI < 8; ++mI) { const float X = cpos + T8[mI + 1] + (hi ? U8[mI + 1] : U8[mI]); f32x16& pv = mI < 4 ? p0 : p1; const f32x16& sv = mI < 4 ? s0 : s1; const int b = 4 * (mI & 3);
                const float e2 = X + sv[b + 3], e1 = e2 + sv[b + 2], e0 = e1 + sv[b + 1];
                pv[b + 3] = __builtin_amdgcn_exp2f(pv[b + 3] - X); pv[b + 2] = __builtin_amdgcn_exp2f(pv[b + 2] - e2);
                pv[b + 1] = __builtin_amdgcn_exp2f(pv[b + 1] - e1); pv[b] = __builtin_amdgcn_exp2f(pv[b] - e0); }
            cpos += T8[0] + U8[0];
            pv_tile(o, p0, p1, vtr);
            if (__all(cpos > -SB_EXIT)) break;
            have = have_next;
        }
        store_o(o, 1.0f, O + (tok0 + r0 + ql) * D + hh * HD, hi);
        if (!has2) break;
        { SB_NEXT_DECODE();
          load_q_frag(qf, QKV + (tok0b + r0b + ql) * QKVB + hhb * HD + 8 * hi);
          if (!nextq) { load_k_tile(kfn, Khb, QKVB, tmaxb * 64, lane); load_v_tile(vrn, Khb + 1024, QKVB, tmaxb * 64, lane); } }
#undef SB_NEXT_DECODE
        item = item2;
    }
}

struct EpiQkv { bf16* O; int ldc; const float* bias; __device__ __forceinline__ void operator()(int r, int c, float v) const {
    if (bias) v += bias[c]; if (c < 1024) v *= QSCALE; O[(size_t)r * ldc + c] = (bf16)f2bf(v); } };
struct EpiOut { float* Z; const float* xres; const float* bias; __device__ __forceinline__ void operator()(int r, int c, float v) const {
    if (bias) v += bias[c]; Z[(size_t)r * D + c] = v + DN_ALPHA * xres[(size_t)r * D + c]; } };

__device__ __forceinline__ void moe_gateup_simple(Frame& F, const bf16* XG, const bf16* WGU  , const float* bgu  , const unsigned* NMT, const unsigned* TILEE, bf16* ACT) {
    const int nmt = (int)NMT[0], j = F.lane & 31, h = F.lane >> 5;
    const int total = nmt * 8 * 32;
    for (int it = F.gw; it < total; it += F.NGW) {
        const int rt = it >> 5, jg = it & 31, row0 = rt * 32, e = (int)TILEE[row0 >> 8], j0 = jg * 32;
        const bf16* W = WGU + (size_t)e * 2048 * D;
        const int ng = 256 * (j0 >> 7) + (j0 & 127), nu = ng + 128;
        f32x16 ag = {}, au = {};
        wave_gemm2(XG + (size_t)(row0 + j) * D + 8 * h, W + (size_t)(ng + j) * D + 8 * h, W + (size_t)(nu + j) * D + 8 * h, D, ag, au);
        const float bg = bgu[e * 2048 + j0 + j], bu = bgu[e * 2048 + 1024 + j0 + j];
#pragma unroll
        for (int r = 0; r < 16; ++r) {
            float gg = fminf(ag[r] + bg, 7.0f), uu = fminf(fmaxf(au[r] + bu, -7.0f), 7.0f);
            const float act = (uu + 1.0f) * (gg / (1.0f + __expf(-1.702f * gg)));
            ACT[(size_t)(row0 + crow(r, h)) * DFF + j0 + j] = (bf16)f2bf(act);
        }
    }
}
__device__ __forceinline__ void moe_down_simple(Frame& F, const bf16* ACT, const bf16* WD, const float* bd  , const float* SGATE, const unsigned* NMT, const unsigned* TILEE, bf16* Y) {
    const int nmt = (int)NMT[0], j = F.lane & 31, h = F.lane >> 5;
    const int total = nmt * 8 * 16;
    for (int it = F.gw; it < total; it += F.NGW) {
        const int rt = it >> 4, cg = it & 15, row0 = rt * 32, e = (int)TILEE[row0 >> 8], c0 = cg * 64;
        const bf16* W = WD + (size_t)e * D * DFF;
        f32x16 a0 = {}, a1 = {};
        wave_gemm2(ACT + (size_t)(row0 + j) * DFF + 8 * h, W + (size_t)(c0 + j) * DFF + 8 * h, W + (size_t)(c0 + 32 + j) * DFF + 8 * h, DFF, a0, a1);
        const float b0 = bd[e * D + c0 + j], b1 = bd[e * D + c0 + 32 + j];
#pragma unroll
        for (int r = 0; r < 16; ++r) { const int row = row0 + crow(r, h); const float gt = SGATE[row];
            Y[(size_t)row * D + c0 + j] = (bf16)f2bf((a0[r] + b0) * gt); Y[(size_t)row * D + c0 + 32 + j] = (bf16)f2bf((a1[r] + b1) * gt); }
    }
}

constexpr int PH_PER_LAYER = 7, N_PHASES = 1 + DEPTH * PH_PER_LAYER;
template <class Tp> __device__ __forceinline__ Tp* launder(Tp* p) { asm volatile("" : "+s"(p)); return p; }
__global__ void __launch_bounds__(NTHREADS, 2) fwd(Args args) {
    extern __shared__ __attribute__((aligned(16))) unsigned char lds[];
    Frame F; F.lds = (LAS unsigned char*)lds; F.tid = threadIdx.x; F.lane = F.tid & 63; F.wave = __builtin_amdgcn_readfirstlane(F.tid >> 6);
    F.gw = blockIdx.x * NWAVES + F.wave; F.NGW = gridDim.x * NWAVES;
#define FRAME() do { int t_ = threadIdx.x; asm volatile("" : "+v"(t_)); F.tid = t_; F.lane = t_ & 63; F.wave = __builtin_amdgcn_readfirstlane(t_ >> 6); F.gw = blockIdx.x * NWAVES + F.wave; } while (0)
    const int lo = args.ph_lo, hi = args.ph_hi;
    for (int u = F.tid; u < 64; u += NTHREADS) ((LAS unsigned*)(F.lds + LDSCTL_OFF))[u] = 0u;
    __syncthreads();
    XcdBarrier bar; bar.bar = (unsigned*)(args.ws + WS_CTL) + CW_BAR; bar.x = 0; bar.st = nullptr;
    if (hi - lo > 1) bar = xcd_barrier_post((unsigned*)(args.ws + WS_CTL) + CW_BAR, (volatile LAS unsigned*)(F.lds + LDSCTL_OFF + 64));
#define IN(k) (lo <= (k) && (k) < hi)
#define SEAM(k) do { if (IN(k) && IN((k) + 1)) for (int rep = 0; rep <= ((PROBE_REPEAT >> 8) & 1); ++rep) { XcdBarrier b2 = bar; b2.bar = launder(bar.bar); asm volatile("" : "+s"(b2.x)); xcd_barrier(b2); } } while (0)
#define WSP(T_, off) ((T_*)(launder(args.ws) + (off)))
    if (IN(0)) for (int rep = 0; rep <= ((PROBE_REPEAT >> 0) & 1); ++rep) { FRAME(); prologue_phase(F, args); }
    SEAM(0);
    for (int i = 0; i < DEPTH; ++i) {
        const int base = 1 + i * PH_PER_LAYER, jl = i >> 1; const bool isA = (i & 1) == 0;
        if (IN(base + 0)) for (int rep = 0; rep <= ((PROBE_REPEAT >> 1) & 1); ++rep) {
            unsigned char* ws = launder(args.ws);
            const int Nq = isA ? QKVA : QKVB;
            const unsigned char* Wt = isA ? ws + WS_WQKVA + (size_t)jl * QKVA * D : ws + WS_WQKVB + (size_t)jl * QKVB * D;
            pg8::Gemm g{(const bf16*)(ws + WS_XB), (const bf16*)Wt, T, Nq, D / 2, 0, nullptr, LT_SB}; pg8::StaticOrder S; S.init(T, Nq, (int)gridDim.x, (int)blockIdx.x);
            pg8::EpiBf16<0> E{(bf16*)(ws + WS_QKV), Nq, isA ? launder(args.in[3]) + (size_t)jl * QKVA : nullptr, 1024, 1024, QSCALE, 1.0f / WGU_SCALE};
            pg8::gemm_phase<pg8::EpiBf16<0>, pg8::StaticOrder, true, true, true, true>(F.lds, g, S, E);
        }
        SEAM(base + 0);
        if (IN(base + 1)) for (int rep = 0; rep <= ((PROBE_REPEAT >> 2) & 1); ++rep) {
            FRAME(); unsigned char* ws = launder(args.ws);
            const int ncv = (CONV_CUS > 0 && (int)gridDim.x >= CONV_CUS + 64) ? (isA ? CONV_CUS_A : CONV_CUS) : 0;
            if ((int)blockIdx.x < ncv) {
                convert_stream<2, false>(F.gw, ncv * NWAVES, F.lane, launder(args.in[17]) + (size_t)i * NEXP * DFF * D, ws + WS_WD + (size_t)i * NEXP * D * DFF, NEXP, DFF, D, (LAS float*)(F.lds + F.wave * CONV_SLOT));
                if (CONV_GU > 0) convert_stream<1, true>(F.gw, ncv * NWAVES, F.lane, launder(args.in[15]) + (size_t)i * NEXP * D * 2 * DFF, ws + WS_WGU + (size_t)i * NEXP * D * 2 * DFF, CONV_GU, D, 2 * DFF, (LAS float*)(F.lds + F.wave * CONV_SLOT));
            } else {
                F.gw -= ncv * NWAVES; F.NGW = ((int)gridDim.x - ncv) * NWAVES;
                if (isA) swa_phase(F, (const bf16*)(ws + WS_QKV), (const float*)(ws + WS_BT), launder(args.in[4]) + jl * NH, ws + WS_O);
                else     sb_phase(F, (const bf16*)(ws + WS_QKV), ws + WS_O);
                F.NGW = (int)gridDim.x * NWAVES;
            }
        }
        SEAM(base + 1);
        if (IN(base + 2)) for (int rep = 0; rep <= ((PROBE_REPEAT >> 3) & 1); ++rep) {
            unsigned char* ws = launder(args.ws);
            const unsigned char* Wt = isA ? ws + WS_WOA + (size_t)jl * D * D : ws + WS_WOB + (size_t)jl * D * D;
            pg8::Gemm g{(const bf16*)(ws + WS_O), (const bf16*)Wt, T, D, D / 2, 0, nullptr, LT_SB}; pg8::StaticOrder S; S.init(T, D, (int)gridDim.x, (int)blockIdx.x);
            pg8::EpiZ16 E{(bf16*)(ws + WS_Z), (const bf16*)(ws + WS_XF), isA ? launder(args.in[6]) + (size_t)jl * D : nullptr, D, DN_ALPHA, 1.0f / (WGU_SCALE * O_SCALE)};
            pg8::gemm_phase<pg8::EpiZ16, pg8::StaticOrder, true, true, true, true>(F.lds, g, S, E);
        }
        SEAM(base + 2);
        if (IN(base + 3)) { FRAME(); unsigned char* ws = launder(args.ws);
            ln1_router_phase(F, (const bf16*)(ws + WS_Z), launder(args.in[9]) + (size_t)i * D, launder(args.in[10]) + (size_t)i * D, (const bf16*)(ws + WS_WRT) + (size_t)i * 2 * NEXP * D, launder(args.in[14]) + (size_t)i * NEXP,
                             (bf16*)(ws + WS_X1F), ws + WS_X18, (int*)(ws + WS_TOPE), (float*)(ws + WS_TOPG), (int*)(ws + WS_POS),
                             (unsigned*)(ws + WS_CTL) + CW_CNT + CNT_LAYER * i, (int*)(ws + WS_LIST), (float*)(ws + WS_LGATE), (int*)(ws + WS_LISTK), 0); }
        SEAM(base + 3);
        if (IN(base + 4)) for (int rep = 0; rep <= ((PROBE_REPEAT >> 5) & 1); ++rep) {
            FRAME(); unsigned char* ws = launder(args.ws);
            moe_tables(F, (unsigned*)(ws + WS_CTL) + CW_CNT + CNT_LAYER * i);
            const int nmt = __builtin_amdgcn_readfirstlane(((const LAS int*)(F.lds + LT_NMT))[0]);
            pg8::Gemm g{(const bf16*)(ws + WS_X18), (const bf16*)(ws + WS_WGU + (size_t)i * NEXP * 2048 * D), nmt * 256, 2048, D / 2, (size_t)2048 * D, (const int*)(ws + WS_LIST), LT_SB};
            pg8::MoeOrder S; S.init(nmt, 2048, (int)gridDim.x, (int)blockIdx.x, (const LAS int*)(F.lds + LT_E), (const LAS int*)(F.lds + LT_TE), (const LAS int*)(F.lds + LT_CNT));
            pg8::EpiSwiglu E{(bf16*)(ws + WS_ACT), launder(args.in[16]) + (size_t)i * NEXP * 2048, 1.0f / WGU_SCALE};
            pg8::gemm_phase<pg8::EpiSwiglu, pg8::MoeOrder, true, true, true, true>(F.lds, g, S, E);
        }
        SEAM(base + 4);
        if (IN(base + 5)) for (int rep = 0; rep <= ((PROBE_REPEAT >> 6) & 1); ++rep) {
            FRAME(); unsigned char* ws = launder(args.ws);
            if (!IN(base + 4)) moe_tables(F, (unsigned*)(ws + WS_CTL) + CW_CNT + CNT_LAYER * i);
            const int nmt = __builtin_amdgcn_readfirstlane(((const LAS int*)(F.lds + LT_NMT))[0]);
            pg8::Gemm g{(const bf16*)(ws + WS_ACT), (const bf16*)(ws + WS_WD + (size_t)i * NEXP * D * DFF), nmt * 256, D, DFF / 2, (size_t)D * DFF, nullptr, LT_SB};
            pg8::MoeOrder S; S.init(nmt, D, (int)gridDim.x, (int)blockIdx.x, (const LAS int*)(F.lds + LT_E), (const LAS int*)(F.lds + LT_TE), (const LAS int*)(F.lds + LT_CNT));
            pg8::EpiDown E{(const int*)(ws + WS_LISTK), (bf16*)(ws + WS_Y), launder(args.in[18]) + (size_t)i * NEXP * D, (const float*)(ws + WS_LGATE), 1.0f / (WD_SCALE * ACT_SCALE)};
            pg8::gemm_phase<pg8::EpiDown, pg8::MoeOrder, true, true, true, true>(F.lds, g, S, E);
        }
        SEAM(base + 5);
        if (IN(base + 6)) for (int rep = 0; rep <= ((PROBE_REPEAT >> 7) & 1); ++rep) { FRAME(); unsigned char* ws = launder(args.ws);
            ln2_phase(F, (const bf16*)(ws + WS_Z), (const float*)(ws + WS_X1F), launder(args.in[9]) + (size_t)i * D, launder(args.in[10]) + (size_t)i * D, (const bf16*)(ws + WS_Y), (const int*)(ws + WS_TOPE), (const int*)(ws + WS_POS), launder(args.in[11]) + (size_t)i * D, launder(args.in[12]) + (size_t)i * D,
                      (bf16*)(ws + WS_XF), launder(args.out), ws + WS_XB, i == DEPTH - 1); }
        SEAM(base + 6);
    }
#undef IN
#undef SEAM
#undef WSP
#undef FRAME
}

#ifndef N_LAUNCHES
#define N_LAUNCHES 1
#endif
extern "C" void kernel_launch(void* const* d_in, const int* in_sizes, int n_in, void* d_out, int out_size, void* d_ws, size_t ws_size, hipStream_t stream) {
    static int grid = 0;
    if (grid == 0) {
        if (n_in != 19 || out_size != T * D || ws_size < WS_END) { fprintf(stderr, "kernel_launch: unexpected shapes (n_in %d out %d ws %zu)\n", n_in, out_size, ws_size); grid = -1; return; }
        int dev = 0, cus = 0, per_cu = 0;
        if (hipGetDevice(&dev) != hipSuccess || hipDeviceGetAttribute(&cus, hipDeviceAttributeMultiprocessorCount, dev) != hipSuccess) { grid = -1; return; }
        if (hipFuncSetAttribute((const void*)fwd, hipFuncAttributeMaxDynamicSharedMemorySize, LDS_BYTES) != hipSuccess) { grid = -1; return; }
        if (hipOccupancyMaxActiveBlocksPerMultiprocessor(&per_cu, (const void*)fwd, NTHREADS, LDS_BYTES) != hipSuccess || per_cu < 1) { fprintf(stderr, "kernel_launch: occupancy query says %d blocks per CU\n", per_cu); (void)hipGetLastError(); }
        grid = cus;
    }
    if (grid < 0) return;
    (void)hipMemsetAsync((char*)d_ws + WS_CTL, 0, CTL_ZERO_BYTES, stream);
    Args a{};
    for (int i = 0; i < 19; ++i) a.in[i] = (const float*)d_in[i];
    a.out = (float*)d_out; a.ws = (unsigned char*)d_ws;
    if (N_LAUNCHES == 1) { a.ph_lo = 0; a.ph_hi = N_PHASES; hipLaunchKernelGGL(fwd, dim3(grid), dim3(NTHREADS), LDS_BYTES, stream, a); }
    else for (int p = 0; p < N_PHASES; ++p) { a.ph_lo = p; a.ph_hi = p + 1; hipLaunchKernelGGL(fwd, dim3(grid), dim3(NTHREADS), LDS_BYTES, stream, a); }
}
```
